# Optimizing an MI355X kernel written in HIP

```python
import math
import jax, jax.numpy as jnp
from jax import lax
import numpy as np

D_MODEL = 1024
BATCH = 16
SEQ = 4096
DEPTH = 4

HEAD_DIM = 64
N_HEADS_A = 8
DILATION_PATTERNS = ((128, 1), (512, 4), (2048, 16))
N_HEADS_B = 8
N_KV_B = 2
WINDOW_B = 128
WA = N_HEADS_A * HEAD_DIM
WB_Q = N_HEADS_B * HEAD_DIM
WB_KV = N_KV_B * HEAD_DIM
MIX_WIDTH = WA + WB_Q
IN_WIDTH = 3 * WA + WB_Q + 2 * WB_KV
ROPE_THETA = 10000.0
N_EXPERTS = 16
D_EXPERT = 1024
CAPACITY_FACTOR = 2
RMS_EPS = 1e-6
NEG_INF = -1e30

kernel_name = "hybrid_longnet_swa_sink_ec_moe_encoder"


def rmsnorm(x, g):
    xf = x.astype(jnp.float32)
    y = xf * lax.rsqrt(jnp.mean(xf * xf, axis=-1, keepdims=True) + RMS_EPS)
    return (y * g.astype(jnp.float32)).astype(x.dtype)


def rope_tables(seq_len):
    inv = 1.0 / (ROPE_THETA ** (jnp.arange(0, HEAD_DIM, 2, dtype=jnp.float32) / HEAD_DIM))
    ang = jnp.arange(seq_len, dtype=jnp.float32)[:, None] * inv[None, :]
    return jnp.cos(ang), jnp.sin(ang)


def apply_rope(t, cos, sin):
    tf = t.astype(jnp.float32)
    t1, t2 = tf[..., : HEAD_DIM // 2], tf[..., HEAD_DIM // 2:]
    out = jnp.concatenate([t1 * cos - t2 * sin, t2 * cos + t1 * sin], axis=-1)
    return out.astype(t.dtype)


def banded_attention(q, k, v, half_window, sink=None):
    w = half_window
    L, hd = q.shape[-2], q.shape[-1]
    nb = -(-L // w)
    pad = nb * w - L
    qp = jnp.pad(q, [(0, 0)] * (q.ndim - 2) + [(0, pad), (0, 0)])
    qb = qp.reshape(q.shape[:-2] + (nb, w, hd))

    def windows(t):
        tp = jnp.pad(t, [(0, 0)] * (t.ndim - 2) + [(w, pad + w), (0, 0)])
        tb = tp.reshape(t.shape[:-2] + (nb + 2, w, hd))
        return jnp.concatenate([tb[..., 0:nb, :, :], tb[..., 1:nb + 1, :, :], tb[..., 2:nb + 2, :, :]], axis=-2)

    kw, vw = windows(k), windows(v)
    s = jnp.einsum('...gbqd,...bkd->...gbqk', qb, kw, preferred_element_type=jnp.float32) * (hd ** -0.5)
    qpos = jnp.arange(nb)[:, None] * w + jnp.arange(w)[None, :]
    kpos = (jnp.arange(nb)[:, None] - 1) * w + jnp.arange(3 * w)[None, :]
    valid = ((jnp.abs(qpos[:, :, None] - kpos[:, None, :]) <= w)
             & (kpos[:, None, :] >= 0) & (kpos[:, None, :] < L))
    s = jnp.where(valid, s, NEG_INF)
    m = jnp.max(s, axis=-1)
    if sink is not None:
        sink_b = jnp.broadcast_to(sink.astype(jnp.float32), m.shape)
        m = jnp.maximum(m, sink_b)
    e = jnp.exp(s - m[..., None])
    denom = jnp.sum(e, axis=-1)
    if sink is not None:
        denom = denom + jnp.exp(sink_b - m)
    p = e / denom[..., None]
    o = jnp.einsum('...gbqk,...bkd->...gbqd', p.astype(v.dtype), vw)
    lse = m + jnp.log(denom)
    o = o.reshape(o.shape[:-4] + (o.shape[-4], nb * w, hd))[..., :L, :]
    lse = lse.reshape(lse.shape[:-2] + (nb * w,))[..., :L]
    return o, lse


def longnet_dilated_attention(q, k, v):
    B, H, S, hd = q.shape
    outs, lses = [], []
    for window, d in DILATION_PATTERNS:
        n = S // d
        qd = q.reshape(B, H, n, d, hd).swapaxes(2, 3)[:, :, :, None]
        kd = k.reshape(B, H, n, d, hd).swapaxes(2, 3)
        vd = v.reshape(B, H, n, d, hd).swapaxes(2, 3)
        o, lse = banded_attention(qd, kd, vd, (window // 2) // d)
        outs.append(o[:, :, :, 0].swapaxes(2, 3).reshape(B, H, S, hd))
        lses.append(lse[:, :, :, 0].swapaxes(2, 3).reshape(B, H, S))
    wts = jax.nn.softmax(jnp.stack(lses, axis=0), axis=0)
    out = sum(wts[i][..., None] * outs[i].astype(jnp.float32) for i in range(len(outs)))
    return out.astype(q.dtype)


def expert_choice_moe(h, w_router, w_gate, w_up, w_down):
    B, S, D = h.shape
    C = min(CAPACITY_FACTOR * S // N_EXPERTS, S)
    logits = jnp.einsum('bsd,de->bse', h, w_router, preferred_element_type=jnp.float32)
    aff = jax.nn.softmax(logits, axis=-1)
    gate, idx = lax.top_k(jnp.swapaxes(aff, 1, 2), C)
    bidx = jnp.arange(B)[:, None, None]
    xe = h[bidx, idx]
    hid = jax.nn.silu(jnp.einsum('becd,edf->becf', xe, w_gate)) * jnp.einsum('becd,edf->becf', xe, w_up)
    ye = jnp.einsum('becf,efd->becd', hid, w_down) * gate[..., None].astype(h.dtype)
    return jnp.zeros_like(h).at[bidx, idx].add(ye)


def setup_inputs(seed: int = 0) -> dict:
    key = jax.random.key(seed)
    ks = jax.random.split(key, 16)
    f32 = jnp.float32
    nrm = lambda k, shape, scale: jax.random.normal(k, shape, f32) * scale
    gain = lambda k, shape: 1.0 + 0.02 * jax.random.normal(k, shape, f32)
    return {
        "x": jax.random.normal(ks[0], (BATCH, SEQ, D_MODEL), f32),
        "w_in": nrm(ks[1], (DEPTH, D_MODEL, IN_WIDTH), D_MODEL ** -0.5),
        "w_out": nrm(ks[2], (DEPTH, MIX_WIDTH, D_MODEL), MIX_WIDTH ** -0.5),
        "g_attn": gain(ks[3], (DEPTH, D_MODEL)),
        "g_mix_a": gain(ks[4], (DEPTH, WA)),
        "g_mix_b": gain(ks[5], (DEPTH, WB_Q)),
        "sink": nrm(ks[6], (DEPTH, N_KV_B, N_HEADS_B // N_KV_B), 1.0),
        "g_ffn": gain(ks[7], (DEPTH, D_MODEL)),
        "w_router": nrm(ks[8], (DEPTH, D_MODEL, N_EXPERTS), D_MODEL ** -0.5),
        "w_gate": nrm(ks[9], (DEPTH, N_EXPERTS, D_MODEL, D_EXPERT), D_MODEL ** -0.5),
        "w_up": nrm(ks[10], (DEPTH, N_EXPERTS, D_MODEL, D_EXPERT), D_MODEL ** -0.5),
        "w_down": nrm(ks[11], (DEPTH, N_EXPERTS, D_EXPERT, D_MODEL), D_EXPERT ** -0.5),
        "g_final": gain(ks[12], (D_MODEL,)),
    }


def reference(x, w_in, w_out, g_attn, g_mix_a, g_mix_b, sink, g_ffn,
              w_router, w_gate, w_up, w_down, g_final):
    B, S, D = x.shape
    cos, sin = rope_tables(S)
    split_pts = np.cumsum([WA, WA, WA, WB_Q, WB_KV])

    def heads(t, n):
        return t.reshape(B, S, n, HEAD_DIM).transpose(0, 2, 1, 3)

    for l in range(DEPTH):
        h = rmsnorm(x, g_attn[l])
        proj = jnp.einsum('bsd,de->bse', h, w_in[l])
        qa, ka, va, qb, kb, vb = jnp.split(proj, split_pts, axis=-1)
        qa = apply_rope(heads(qa, N_HEADS_A), cos, sin)
        ka = apply_rope(heads(ka, N_HEADS_A), cos, sin)
        oa = longnet_dilated_attention(qa, ka, heads(va, N_HEADS_A))
        oa = oa.transpose(0, 2, 1, 3).reshape(B, S, WA)
        g = N_HEADS_B // N_KV_B
        qb = apply_rope(heads(qb, N_HEADS_B), cos, sin).reshape(B, N_KV_B, g, S, HEAD_DIM)
        kb = apply_rope(heads(kb, N_KV_B), cos, sin)
        ob, _ = banded_attention(qb, kb, heads(vb, N_KV_B), WINDOW_B, sink=sink[l][:, :, None, None])
        ob = ob.reshape(B, N_HEADS_B, S, HEAD_DIM).transpose(0, 2, 1, 3).reshape(B, S, WB_Q)
        mix = jnp.concatenate([rmsnorm(oa, g_mix_a[l]), rmsnorm(ob, g_mix_b[l])], axis=-1)
        x = x + jnp.einsum('bse,ed->bsd', mix, w_out[l])
        h2 = rmsnorm(x, g_ffn[l])
        x = x + expert_choice_moe(h2, w_router[l], w_gate[l], w_up[l], w_down[l])
    return rmsnorm(x, g_final)
```

```cpp
#include <hip/hip_runtime.h>
#include <cstdio>
#include <cstdint>

constexpr int BATCH = 16, SEQ = 4096, DM = 1024, DEPTH = 4, HD = 64;
constexpr int MTOK = BATCH * SEQ;
constexpr int INW = 2304;
constexpr int NE = 16, DF = 1024, CAP = 512;
constexpr float RMS_EPS = 1e-6f;
constexpr float LOG2E = 1.4426950408889634f;
constexpr float QSCALE = 0.125f * LOG2E;

constexpr size_t MiB = 1u << 20;
constexpr size_t WS_CTL = 0, CTL_ZERO_BYTES = 64 * 1024;
constexpr size_t WS_ROPE = 1 * MiB;
constexpr size_t WS_AFF = 2 * MiB;
constexpr size_t WS_IDX = 6 * MiB;
constexpr size_t WS_GATE = 7 * MiB;
constexpr size_t WS_INV = 8 * MiB;
constexpr size_t WS_LSE = 10 * MiB;
constexpr size_t WS_RS1 = 6 * MiB + 512 * 1024;
constexpr size_t WS_RS2 = 6 * MiB + 768 * 1024;
constexpr size_t WS_RSS = 7 * MiB + 512 * 1024;
constexpr size_t WS_WIN = 16 * MiB;
constexpr size_t WS_WOUT = 21 * MiB;
constexpr size_t WS_WGU = 24 * MiB;
constexpr size_t WS_WD = 88 * MiB;
constexpr size_t WS_ACT = 120 * MiB;
constexpr size_t WS_PROJ = 248 * MiB;
constexpr size_t WS_ATT = 536 * MiB;
constexpr size_t WS_XB = 792 * MiB;
constexpr size_t WS_END = 920 * MiB;

constexpr int LDS_BYTES = 147456;
constexpr int RING_BYTES = 131072;
constexpr int MISC_OFF = RING_BYTES;

#define GAS __attribute__((address_space(1)))
#define LAS __attribute__((address_space(3)))
typedef unsigned short bf16_t;
typedef short bf16x8 __attribute__((ext_vector_type(8)));
typedef float f32x4 __attribute__((ext_vector_type(4)));
typedef unsigned u32x4 __attribute__((ext_vector_type(4)));
typedef unsigned u32x2 __attribute__((ext_vector_type(2)));

__device__ __forceinline__ unsigned f2bf(float f) { unsigned u = __builtin_bit_cast(unsigned, f); return (u + 0x7fffu + ((u >> 16) & 1u)) >> 16; }
__device__ __forceinline__ unsigned pk2(float lo, float hi) { return f2bf(lo) | (f2bf(hi) << 16); }
__device__ __forceinline__ float bflo(unsigned w) { return __builtin_bit_cast(float, w << 16); }
__device__ __forceinline__ float bfhi(unsigned w) { return __builtin_bit_cast(float, w & 0xffff0000u); }
__device__ __forceinline__ unsigned cvt_pk_bf16(float lo, float hi) { unsigned r; asm volatile("v_cvt_pk_bf16_f32 %0, %1, %2" : "=v"(r) : "v"(lo), "v"(hi)); return r; }
__device__ __forceinline__ float wave_sum(float v) {
#pragma unroll
    for (int o = 1; o < 64; o <<= 1) v += __shfl_xor(v, o);
    return v;
}
#define LDS_WAIT() asm volatile("s_waitcnt lgkmcnt(0)" ::: "memory")
#define GAS __attribute__((address_space(1)))

#define XB_TMO      128
#define XB_XCNT(j)  (256  + 64 * (j))
#define XB_XSUB(j)  (1280 + 64 * (j))
#define XB_XGEN(j)  (2304 + 64 * (j))
#define XB_TOP      3328
#define XB_TOPGEN   3392
#define XCD_BAR_WORDS 3456
#define XB_SPIN_CAP (1u << 23)

__device__ __forceinline__ unsigned xb_ld(unsigned* p)              { return __hip_atomic_load(p, __ATOMIC_RELAXED, __HIP_MEMORY_SCOPE_AGENT); }
__device__ __forceinline__ unsigned xb_add(unsigned* p, unsigned v) { return __hip_atomic_fetch_add(p, v, __ATOMIC_RELAXED, __HIP_MEMORY_SCOPE_AGENT); }
__device__ __forceinline__ unsigned xb_xcc_id() { return (unsigned)__builtin_amdgcn_s_getreg((3 << 11) | 20) & 0xFu; }
#define XB_SPIN(cond, bar) do { unsigned _sp = 0; while (cond) { __builtin_amdgcn_s_sleep(1); \
    if ((++_sp & 255u) == 0u) { if (xb_ld(&(bar)[XB_TMO])) break; if (_sp > XB_SPIN_CAP) { atomicAdd(&(bar)[XB_TMO], 1u); break; } } } } while (0)

struct XcdBarrier { unsigned* bar; unsigned x; volatile LAS unsigned* st; };

__device__ __forceinline__ XcdBarrier xcd_barrier_post(unsigned* bar, volatile LAS unsigned* st) {
    XcdBarrier b; b.bar = bar; b.x = xb_xcc_id(); b.st = st;
    if (threadIdx.x == 0) (void)xb_add(&bar[XB_XCNT(b.x)], 1u);
    return b;
}
__device__ __forceinline__ void xcd_barrier_complete(unsigned* bar, unsigned x, unsigned& nloc, unsigned& nx) {
    const unsigned G = gridDim.x * gridDim.y * gridDim.z;
    unsigned sum, cnt, mine, sp = 0u;
    for (;;) {
        sum = 0u; cnt = 0u; mine = 0u;
#pragma unroll
        for (unsigned j = 0; j < 16; ++j) { const unsigned c = xb_ld(&bar[XB_XCNT(j)]); sum += c; cnt += (c > 0u) ? 1u : 0u; mine = (j == x) ? c : mine; }
        if (sum == G) break;
        __builtin_amdgcn_s_sleep(1);
        if ((++sp & 255u) == 0u) { if (xb_ld(&bar[XB_TMO])) break; if (sp > XB_SPIN_CAP) { atomicAdd(&bar[XB_TMO], 1u); break; } }
    }
    nloc = mine > 0u ? mine : 1u; nx = cnt > 0u ? cnt : 1u;
}
__device__ __forceinline__ void xcd_barrier(const XcdBarrier& b) {
    asm volatile("s_waitcnt vmcnt(0)" ::: "memory");
    __syncthreads();
    if (threadIdx.x == 0) {
        unsigned* bar = b.bar;
        __builtin_amdgcn_s_waitcnt(0);
        unsigned nloc = b.st[0], nx = b.st[1];
        if (nloc == 0u) { xcd_barrier_complete(bar, b.x, nloc, nx); b.st[0] = nloc; b.st[1] = nx; }
        const unsigned old = xb_add(&bar[XB_XSUB(b.x)], 1u);
        const unsigned gen = old / nloc;
        if (old + 1u == (gen + 1u) * nloc) {
            __builtin_amdgcn_fence(__ATOMIC_RELEASE, "agent");
            asm volatile("s_waitcnt vmcnt(0)" ::: "memory");
            const unsigned og = xb_add(&bar[XB_TOP], 1u);
            const unsigned tg = og / nx;
            if (og + 1u == (tg + 1u) * nx) xb_add(&bar[XB_TOPGEN], 1u);
            else XB_SPIN(xb_ld(&bar[XB_TOPGEN]) == tg, bar);
            __builtin_amdgcn_fence(__ATOMIC_ACQUIRE, "agent");
            xb_add(&bar[XB_XGEN(b.x)], 1u);
            asm volatile("s_waitcnt vmcnt(0)" ::: "memory");
        } else {
            XB_SPIN(xb_ld(&bar[XB_XGEN(b.x)]) == gen, bar);
            __builtin_amdgcn_fence(__ATOMIC_ACQUIRE, "agent");
            asm volatile("s_waitcnt vmcnt(0)" ::: "memory");
        }
    }
    __syncthreads();
}

namespace pg8 {
constexpr int BM = 256, BK = 64, HALF = 128, HTB = HALF * BK * 2, STAGE_BYTES = 8 * HTB;
__host__ __device__ __forceinline__ int lds_byte(int r, int c) { const int st = (r >> 4) * 2 + (c >> 5), rr = r & 15, cc = c & 31, ob = rr * 64 + cc * 2; return st * 1024 + (ob ^ (((ob >> 9) & 1) << 5)); }
__host__ __device__ __forceinline__ void stage_rc(int b, int& R, int& C) { const int st = b / 1024, sb = b % 1024, swz = sb ^ (((sb >> 9) & 1) << 5); R = (st >> 1) * 16 + swz / 64; C = (st & 1) * 32 + (swz % 64) / 2; }
__host__ __device__ __forceinline__ int perm32(int rho) { const int n = rho >> 4, i = rho & 15; return 8 * (i >> 2) + 4 * n + (i & 3); }

struct Unit { int pm, pn, grp; };

struct StaticOrder {
    int nM, nN, nwg, G, c;
    __device__ void init(int M, int N, int G_, int c_) { nM = M / BM; nN = N / BM; nwg = nM * nN; G = G_; c = c_; }
    __device__ bool next(int i, Unit& u) const {
        const long L = (long)i * G + c; if (L >= nwg) return false;
        int wgid = (int)L; { const int q = nwg / 8, r = nwg % 8, xcd = wgid % 8, off = wgid / 8; wgid = (xcd < r ? xcd * (q + 1) : r * (q + 1) + (xcd - r) * q) + off; }
        const int nig = 8 * nN, gid = wgid / nig, fm = gid * 8, gsz = (nM - fm) < 8 ? (nM - fm) : 8;
        u.pm = fm + ((wgid % nig) % gsz); u.pn = (wgid % nig) / gsz; u.grp = 0; return true;
    }
};
template <int NPN_LOG2, bool REV = false> struct GroupOrder {
    int G, x, s, per, slots;
    __device__ void init(int G_, int c) { G = G_; if (G % 8 == 0) { x = c % 8; s = c / 8; slots = G / 8; per = (512 << NPN_LOG2) / 8; } else { x = 0; s = c; slots = G; per = 512 << NPN_LOG2; } }
    __device__ bool next(int i, Unit& u) const {
        if (i * slots + s >= per) return false;
        const int rounds = (per - s + slots - 1) / slots;
        const int w = (REV ? (rounds - 1 - i) : i) * slots + s;
        const int per_e = 32 << NPN_LOG2;
        int e, r;
        if (G % 8 == 0) { e = 2 * x + w / per_e; r = w % per_e; } else { e = w / per_e; r = w % per_e; }
        int bt, pn;
        if (NPN_LOG2 == 3) {
            const int ph = r >> 7, rr = (r >> 5) & 3, sl = r & 31; bt = rr * 8 + (sl & 7); pn = ph * 4 + (sl >> 3);
        } else { bt = r >> NPN_LOG2; pn = r & ((1 << NPN_LOG2) - 1); }
        u.pn = pn; u.pm = bt & 1; u.grp = (bt >> 1) * NE + e; return true;
    }
};

struct PlainAB {
    static constexpr bool GATHER = false;
    const bf16_t* A; const bf16_t* Bt; int K;
    __device__ __forceinline__ const char* a_base(const Unit& u) const { return (const char*)A + (size_t)u.pm * BM * K * 2; }
    __device__ __forceinline__ const char* b_base(const Unit& u) const { return (const char*)Bt + (size_t)u.pn * BM * K * 2; }
    __device__ __forceinline__ int gidx(const Unit&, int) const { return 0; }
};
struct GroupAB {
    static constexpr bool GATHER = false;
    const bf16_t* A; const bf16_t* Bt; int K; int N;
    __device__ __forceinline__ const char* a_base(const Unit& u) const { return (const char*)A + ((size_t)u.grp * 512 + (size_t)u.pm * BM) * K * 2; }
    __device__ __forceinline__ const char* b_base(const Unit& u) const { return (const char*)Bt + ((size_t)(u.grp & (NE - 1)) * N + (size_t)u.pn * BM) * K * 2; }
    __device__ __forceinline__ int gidx(const Unit&, int) const { return 0; }
};
struct GatherAB {
    static constexpr bool GATHER = true;
    const bf16_t* X; const int* idx; const bf16_t* Bt; int K; int N;
    __device__ __forceinline__ const char* a_base(const Unit& u) const { return (const char*)X + (size_t)(u.grp / NE) * SEQ * K * 2; }
    __device__ __forceinline__ const char* b_base(const Unit& u) const { return (const char*)Bt + ((size_t)(u.grp & (NE - 1)) * N + (size_t)u.pn * BM) * K * 2; }
    __device__ __forceinline__ int gidx(const Unit& u, int r) const { return idx[u.grp * CAP + u.pm * BM + r]; }
};

template <class Epi, class Sched, class AB>
__device__ __forceinline__ void gemm_phase(LAS unsigned char* lds, const AB ab, const Sched& S, const Epi& E) {
    int tid_ = threadIdx.x; asm volatile("" : "+v"(tid_));
    const int tid = tid_, wid = __builtin_amdgcn_readfirstlane(tid >> 6), lane = tid & 63, wr = wid >> 2, wc = wid & 3, fr = lane & 15, fq = lane >> 4;
    const int K = ab.K, nt = K / BK;
    unsigned voffA[2][2], voffB[2];
    int Rr[2], Cc[2];
#pragma unroll
    for (int i = 0; i < 2; ++i) { int R, C; stage_rc(tid * 16 + i * 8192, R, C); Rr[i] = R; Cc[i] = C; const int Rb = Epi::PERM ? ((R & ~31) + perm32(R & 31)) : R;
        voffA[0][i] = (unsigned)(R * K + C) * 2u; voffA[1][i] = voffA[0][i]; voffB[i] = (unsigned)(Rb * K + C) * 2u; }
    const size_t kstep = (size_t)(BK * 2);
    const size_t hstepB = (size_t)HALF * K * 2;
    const size_t hstepA = AB::GATHER ? 0 : hstepB;
    const unsigned ldsw = (unsigned)wid * 1024u;
    const int aoff = lds_byte(wr * 64 + fr, fq * 8), boff = lds_byte(wc * 32 + fr, fq * 8);
#define PG8_SA(b, h) (((b) * 2 + (h)) * HTB)
#define PG8_SB(b, h) ((4 + (b) * 2 + (h)) * HTB)
#define PG8_STAGE(bufoff, gbase, voff) do { _Pragma("unroll") for (int _i = 0; _i < 2; ++_i) \
        __builtin_amdgcn_global_load_lds((const unsigned*)((const char*)(gbase) + (voff)[_i]), (LAS unsigned*)(lds + (bufoff) + ldsw + _i * 8192), 16, 0, 0); } while (0)
#define PG8_LDA(dst, b, h) do { _Pragma("unroll") for (int m = 0; m < 4; ++m) _Pragma("unroll") for (int k = 0; k < 2; ++k) dst[m][k] = *(const LAS bf16x8*)(lds + PG8_SA(b, h) + aoff + m * 2048 + k * 1024); } while (0)
#define PG8_LDB(dst, b, h) do { _Pragma("unroll") for (int n = 0; n < 2; ++n) _Pragma("unroll") for (int k = 0; k < 2; ++k) dst[n][k] = *(const LAS bf16x8*)(lds + PG8_SB(b, h) + boff + n * 2048 + k * 1024); } while (0)
#define PG8_MMA(ai, bj, At, Bt) do { __builtin_amdgcn_s_setprio(1); _Pragma("unroll") for (int m = 0; m < 4; ++m) _Pragma("unroll") for (int n = 0; n < 2; ++n) _Pragma("unroll") for (int k = 0; k < 2; ++k) \
        acc[ai][bj][m][n] = __builtin_amdgcn_mfma_f32_16x16x32_bf16(Bt[n][k], At[m][k], acc[ai][bj][m][n], 0, 0, 0); __builtin_amdgcn_s_setprio(0); } while (0)
#define PG8_WAIT_V(n) asm volatile("s_waitcnt vmcnt(" #n ")" ::: "memory")
#define PG8_WAIT_L(n) asm volatile("s_waitcnt lgkmcnt(" #n ")" ::: "memory")
#define PG8_BAR __builtin_amdgcn_s_barrier()
#define PG8_SCHED __builtin_amdgcn_sched_barrier(0)
    Unit cur, nxt; int ui = 0;
    if (!S.next(0, cur)) return;
    __builtin_amdgcn_s_waitcnt(0);
    f32x4 acc[2][2][4][2];
#pragma unroll
    for (int a = 0; a < 2; ++a)
#pragma unroll
        for (int b = 0; b < 2; ++b)
#pragma unroll
            for (int m = 0; m < 4; ++m)
#pragma unroll
                for (int n = 0; n < 2; ++n) acc[a][b][m][n] = (f32x4){0.f, 0.f, 0.f, 0.f};
    bf16x8 At[4][2], B0[2][2], B1[2][2];
    const char* cA = ab.a_base(cur); const char* cB = ab.b_base(cur);
    if constexpr (AB::GATHER) {
#pragma unroll
        for (int h = 0; h < 2; ++h)
#pragma unroll
            for (int i = 0; i < 2; ++i) voffA[h][i] = (unsigned)(ab.gidx(cur, h * HALF + Rr[i]) * K + Cc[i]) * 2u;
    }
    PG8_STAGE(PG8_SB(0, 0), cB, voffB); PG8_STAGE(PG8_SB(0, 1), cB + hstepB, voffB); PG8_STAGE(PG8_SA(0, 0), cA, voffA[0]); PG8_STAGE(PG8_SA(0, 1), cA + hstepA, voffA[1]);
    if (wr == 1) PG8_BAR;
    PG8_WAIT_V(2); PG8_BAR;
    PG8_STAGE(PG8_SB(1, 0), cB + kstep, voffB); PG8_STAGE(PG8_SA(1, 0), cA + kstep, voffA[0]); PG8_STAGE(PG8_SB(1, 1), cB + hstepB + kstep, voffB);
    PG8_WAIT_V(6); PG8_BAR;
    for (;;) {
        const bool has_next = S.next(ui + 1, nxt);
        const char* nA = has_next ? ab.a_base(nxt) : cA; const char* nB = has_next ? ab.b_base(nxt) : cB;
        for (int t = 0; t < nt; t += 2) {
            const bool last = (t == nt - 2);
            const char* a1 = cA + (size_t)(t + 1) * kstep;
            const char* a2 = last ? nA : cA + (size_t)(t + 2) * kstep; const char* b2 = last ? nB : cB + (size_t)(t + 2) * kstep;
            const char* a3 = a2 + kstep; const char* b3 = b2 + kstep;
            int nidx[2][2];
            if constexpr (AB::GATHER) { if (last && has_next) {
#pragma unroll
                for (int h = 0; h < 2; ++h)
#pragma unroll
                    for (int i = 0; i < 2; ++i) nidx[h][i] = ab.gidx(nxt, h * HALF + Rr[i]); } }
            PG8_LDB(B0, 0, 0); PG8_LDB(B1, 0, 1); PG8_SCHED; PG8_LDA(At, 0, 0); PG8_STAGE(PG8_SA(1, 1), a1 + hstepA, voffA[1]);
            PG8_WAIT_V(8); PG8_WAIT_L(0); PG8_BAR; PG8_MMA(0, 0, At, B0); PG8_MMA(0, 1, At, B1); PG8_BAR; PG8_SCHED;
            if constexpr (AB::GATHER) { if (last && has_next) {
#pragma unroll
                for (int h = 0; h < 2; ++h)
#pragma unroll
                    for (int i = 0; i < 2; ++i) voffA[h][i] = (unsigned)(nidx[h][i] * K + Cc[i]) * 2u; } }
            PG8_LDA(At, 0, 1); PG8_STAGE(PG8_SB(0, 0), b2, voffB); PG8_STAGE(PG8_SB(0, 1), b2 + hstepB, voffB); PG8_STAGE(PG8_SA(0, 0), a2, voffA[0]);
            PG8_WAIT_V(8); PG8_WAIT_L(0); PG8_BAR; PG8_MMA(1, 0, At, B0); PG8_MMA(1, 1, At, B1); PG8_BAR; PG8_SCHED;
            PG8_LDB(B0, 1, 0); PG8_LDB(B1, 1, 1); PG8_SCHED; PG8_LDA(At, 1, 0); PG8_STAGE(PG8_SA(0, 1), a2 + hstepA, voffA[1]);
            PG8_WAIT_V(8); PG8_WAIT_L(0); PG8_BAR; PG8_MMA(0, 0, At, B0); PG8_MMA(0, 1, At, B1); PG8_BAR; PG8_SCHED;
            PG8_LDA(At, 1, 1); PG8_STAGE(PG8_SB(1, 0), b3, voffB); PG8_STAGE(PG8_SB(1, 1), b3 + hstepB, voffB); PG8_STAGE(PG8_SA(1, 0), a3, voffA[0]);
            PG8_WAIT_V(8); PG8_WAIT_L(0); PG8_BAR; PG8_MMA(1, 0, At, B0); PG8_MMA(1, 1, At, B1); PG8_BAR; PG8_SCHED;
        }
        if (wr == 0) PG8_BAR;
        E(acc, cur, wr, wc, fr, fq);
        if (!has_next) break;
#pragma unroll
        for (int a = 0; a < 2; ++a)
#pragma unroll
            for (int b = 0; b < 2; ++b)
#pragma unroll
                for (int m = 0; m < 4; ++m)
#pragma unroll
                    for (int n = 0; n < 2; ++n) acc[a][b][m][n] = (f32x4){0.f, 0.f, 0.f, 0.f};
        cur = nxt; cA = nA; cB = nB; ++ui;
        if (wr == 1) PG8_BAR;
    }
    PG8_WAIT_V(0);
    PG8_BAR;
#undef PG8_SA
#undef PG8_SB
#undef PG8_STAGE
#undef PG8_LDA
#undef PG8_LDB
#undef PG8_MMA
#undef PG8_WAIT_V
#undef PG8_WAIT_L
#undef PG8_BAR
#undef PG8_SCHED
}


struct EpiRope {
    static constexpr bool PERM = true;
    bf16_t* O; const float* cosT; const float* sinT; const float* rs;
    __device__ __forceinline__ void operator()(const f32x4 (&acc)[2][2][4][2], const Unit& u, int wr, int wc, int fr, int fq) const {
        const int row0 = u.pm * BM + wr * 64 + fr;
        const int g4 = 4 * (4 * (wc & 1) + fq);
        bool rope[2]; float qs[2];
#pragma unroll
        for (int bj = 0; bj < 2; ++bj) { const int cb = u.pn * BM + bj * HALF; rope[bj] = (cb < 1024) || (cb >= 1536 && cb < 2176); qs[bj] = ((cb < 512) || (cb >= 1536 && cb < 2048)) ? QSCALE : 1.0f; }
#pragma unroll
        for (int ai = 0; ai < 2; ++ai) {
            f32x4 csv[4], snv[4]; float rsr[4];
#pragma unroll
            for (int m = 0; m < 4; ++m) { const int row = row0 + ai * HALF + m * 16, pos = row & (SEQ - 1); csv[m] = *(const f32x4*)(cosT + pos * 32 + g4); snv[m] = *(const f32x4*)(sinT + pos * 32 + g4); rsr[m] = rs[row]; }
#pragma unroll
            for (int m = 0; m < 4; ++m) {
                const int row = row0 + ai * HALF + m * 16;
                const float rsv = rsr[m];
                const f32x4 cs = csv[m], sn = snv[m];
                bf16_t* rowp = O + (size_t)row * INW + u.pn * BM + wc * 32 + 8 * fq;
#pragma unroll
                for (int bj = 0; bj < 2; ++bj) {
                    const f32x4 v0 = acc[ai][bj][m][0], v1 = acc[ai][bj][m][1];
                    const f32x4 ce = rope[bj] ? cs : (f32x4){1.f, 1.f, 1.f, 1.f}, se = rope[bj] ? sn : (f32x4){0.f, 0.f, 0.f, 0.f};
                    f32x4 o0 = v0 * ce - v1 * se, o1 = v1 * ce + v0 * se;
                    const float sc = qs[bj] * rsv; o0 = o0 * sc; o1 = o1 * sc;
                    u32x4 w; w.x = cvt_pk_bf16(o0[0], o0[1]); w.y = cvt_pk_bf16(o0[2], o0[3]); w.z = cvt_pk_bf16(o1[0], o1[1]); w.w = cvt_pk_bf16(o1[2], o1[3]);
                    *(u32x4*)(rowp + bj * HALF) = w;
                }
            }
            asm volatile("" ::: "memory");
        }
    }
};
struct EpiResid {
    static constexpr bool PERM = true;
    bf16_t* X;
    __device__ __forceinline__ void operator()(const f32x4 (&acc)[2][2][4][2], const Unit& u, int wr, int wc, int fr, int fq) const {
        const int row0 = u.pm * BM + wr * 64 + fr, col0 = u.pn * BM + wc * 32 + 8 * fq;
#pragma unroll
        for (int ai = 0; ai < 2; ++ai) {
            u32x4 rv[4][2];
#pragma unroll
            for (int m = 0; m < 4; ++m)
#pragma unroll
                for (int bj = 0; bj < 2; ++bj) rv[m][bj] = *(const u32x4*)(X + (size_t)(row0 + ai * HALF + m * 16) * DM + col0 + bj * HALF);
#pragma unroll
            for (int m = 0; m < 4; ++m)
#pragma unroll
                for (int bj = 0; bj < 2; ++bj) { const u32x4 q = rv[m][bj]; const f32x4 v0 = acc[ai][bj][m][0], v1 = acc[ai][bj][m][1];
                    u32x4 w; w.x = cvt_pk_bf16(bflo(q.x) + v0[0], bfhi(q.x) + v0[1]); w.y = cvt_pk_bf16(bflo(q.y) + v0[2], bfhi(q.y) + v0[3]);
                    w.z = cvt_pk_bf16(bflo(q.z) + v1[0], bfhi(q.z) + v1[1]); w.w = cvt_pk_bf16(bflo(q.w) + v1[2], bfhi(q.w) + v1[3]);
                    *(u32x4*)(X + (size_t)(row0 + ai * HALF + m * 16) * DM + col0 + bj * HALF) = w; }
        }
    }
};
struct EpiSwiglu {
    static constexpr bool PERM = true;
    bf16_t* H; const float* rss;
    __device__ __forceinline__ void operator()(const f32x4 (&acc)[2][2][4][2], const Unit& u, int wr, int wc, int fr, int fq) const {
        const int row0 = u.grp * CAP + u.pm * BM + wr * 64 + fr, col0 = u.pn * HALF + wc * 32 + 8 * fq;
        float rsa[2][4];
#pragma unroll
        for (int ai = 0; ai < 2; ++ai)
#pragma unroll
            for (int m = 0; m < 4; ++m) rsa[ai][m] = rss[row0 + ai * HALF + m * 16];
#pragma unroll
        for (int ai = 0; ai < 2; ++ai)
#pragma unroll
            for (int m = 0; m < 4; ++m) {
                float hv[8]; const float rsv = rsa[ai][m];
#pragma unroll
                for (int n = 0; n < 2; ++n)
#pragma unroll
                    for (int j = 0; j < 4; ++j) { const float g = acc[ai][0][m][n][j] * rsv, up = acc[ai][1][m][n][j] * rsv; const float e = __builtin_amdgcn_exp2f(-g * LOG2E); hv[4 * n + j] = g * up * __builtin_amdgcn_rcpf(1.0f + e); }
                u32x4 w; w.x = cvt_pk_bf16(hv[0], hv[1]); w.y = cvt_pk_bf16(hv[2], hv[3]); w.z = cvt_pk_bf16(hv[4], hv[5]); w.w = cvt_pk_bf16(hv[6], hv[7]);
                *(u32x4*)(H + (size_t)(row0 + ai * HALF + m * 16) * DF + col0) = w;
            }
    }
};
struct EpiDown {
    static constexpr bool PERM = true;
    bf16_t* Y; const float* gate;
    __device__ __forceinline__ void operator()(const f32x4 (&acc)[2][2][4][2], const Unit& u, int wr, int wc, int fr, int fq) const {
        const int row0 = u.grp * CAP + u.pm * BM + wr * 64 + fr, col0 = u.pn * BM + wc * 32 + 8 * fq;
        float gta[2][4];
#pragma unroll
        for (int ai = 0; ai < 2; ++ai)
#pragma unroll
            for (int m = 0; m < 4; ++m) gta[ai][m] = gate[row0 + ai * HALF + m * 16];
#pragma unroll
        for (int ai = 0; ai < 2; ++ai)
#pragma unroll
            for (int m = 0; m < 4; ++m) { const int row = row0 + ai * HALF + m * 16; const float gt = gta[ai][m];
#pragma unroll
                for (int bj = 0; bj < 2; ++bj) { const f32x4 v0 = acc[ai][bj][m][0] * gt, v1 = acc[ai][bj][m][1] * gt;
                    u32x4 w; w.x = cvt_pk_bf16(v0[0], v0[1]); w.y = cvt_pk_bf16(v0[2], v0[3]); w.z = cvt_pk_bf16(v1[0], v1[1]); w.w = cvt_pk_bf16(v1[2], v1[3]);
                    *(u32x4*)(Y + (size_t)row * DM + col0 + bj * HALF) = w; } }
    }
};
}

struct Params { const float* in[13]; float* out; unsigned char* ws; int ph_lo, ph_hi; };
enum { I_X = 0, I_WIN, I_WOUT, I_GATTN, I_GMIXA, I_GMIXB, I_SINK, I_GFFN, I_WROUTER, I_WGATE, I_WUP, I_WDOWN, I_GFINAL };
constexpr int NPH = 9;
constexpr int PH_TOTAL = DEPTH * NPH + 1;

struct Ctx {
    LAS unsigned char* lds;
    int tid, lane, wave, G, gw, NGW;
    const GAS float* const GAS* in; GAS float* out; GAS unsigned char* ws;
};

template <int MODE>
__device__ __forceinline__ int dst_row(int n) {
    if (MODE == 0) { if ((n < 1024) || (n >= 1536 && n < 2176)) { const int d = n & 63, base = n - d; const int p = (d < 32) ? (8 * (d >> 2) + (d & 3)) : (8 * ((d - 32) >> 2) + 4 + (d & 3)); return base + p; } return n; }
    if (MODE == 2) return (n >> 7) * 256 + (n & 127);
    if (MODE == 3) return (n >> 7) * 256 + 128 + (n & 127);
    return n;
}
template <int MODE>
__device__ __forceinline__ void transpose_item(const GAS float* W, int K, int N, bf16_t* WT, const GAS float* gain, LAS float* scr, int item, int lane) {
    const int nblk = N / 32, kb = item / nblk, nb = item % nblk, k0 = 64 * kb, n0 = 32 * nb;
    float wv[32];
#pragma unroll
    for (int i = 0; i < 32; ++i) wv[i] = W[(size_t)(k0 + 2 * i + (lane >> 5)) * N + n0 + (lane & 31)];
    const float g0 = gain ? gain[k0 + lane] : 1.0f;
#pragma unroll
    for (int i = 0; i < 32; ++i) { const int kk = 2 * i + (lane >> 5); const float gv = __shfl(g0, kk); scr[kk * 33 + (lane & 31)] = wv[i] * gv; }
    LDS_WAIT(); asm volatile("" ::: "memory");
    const int c = lane & 7;
#pragma unroll
    for (int j = 0; j < 4; ++j) { const int n = (lane >> 3) + 8 * j; const LAS float* s = scr + (8 * c) * 33 + n;
        u32x4 o; o.x = pk2(s[0 * 33], s[1 * 33]); o.y = pk2(s[2 * 33], s[3 * 33]); o.z = pk2(s[4 * 33], s[5 * 33]); o.w = pk2(s[6 * 33], s[7 * 33]);
        *(u32x4*)(WT + (size_t)dst_row<MODE>(n0 + n) * K + k0 + 8 * c) = o; }
    LDS_WAIT(); asm volatile("" ::: "memory");
}
__device__ __forceinline__ void sincos_acc(float x, float& s, float& c) {
    int j = (int)(x * 1.27323954473516f); j = (j + 1) & ~1;
    const float y = (float)j;
    float z = __builtin_fmaf(-y, 0.78515625f, x); z = __builtin_fmaf(-y, 2.4187564849853515625e-4f, z); z = __builtin_fmaf(-y, 3.77489497744594108e-8f, z);
    const float zz = z * z;
    const float ps = ((-1.9515295891e-4f * zz + 8.3321608736e-3f) * zz - 1.6666654611e-1f) * zz * z + z;
    const float pc = ((2.443315711809948e-5f * zz - 1.388731625493765e-3f) * zz + 4.166664568298827e-2f) * zz * zz - 0.5f * zz + 1.0f;
    const int q = (j >> 1) & 3;
    s = (q == 0) ? ps : (q == 1) ? pc : (q == 2) ? -ps : -pc;
    c = (q == 0) ? pc : (q == 1) ? -ps : (q == 2) ? -pc : ps;
}
__device__ __forceinline__ void phase_weights(const Ctx& c, int l) {
    LAS float* scr = (LAS float*)(c.lds + c.wave * 16384);
    bf16_t* Win = (bf16_t*)(c.ws + WS_WIN); bf16_t* Wout = (bf16_t*)(c.ws + WS_WOUT); bf16_t* Wgu = (bf16_t*)(c.ws + WS_WGU); bf16_t* Wd = (bf16_t*)(c.ws + WS_WD);
    constexpr int I_IN = 16 * (INW / 32), I_OUT = 16 * 32, I_EXP = 16 * 32;
    constexpr int NITEMS = I_IN + I_OUT + 3 * NE * I_EXP;
    for (int it = c.gw; it < NITEMS; it += c.NGW) {
        int r = it;
        if (r < I_IN) { transpose_item<0>(c.in[I_WIN] + (size_t)l * DM * INW, DM, INW, Win, c.in[I_GATTN] + l * DM, scr, r, c.lane); continue; } r -= I_IN;
        if (r < I_OUT) { const int k0 = 64 * (r / 32); const GAS float* ga = (k0 < 512) ? (c.in[I_GMIXA] + l * 512) : (c.in[I_GMIXB] + l * 512 - 512);
            transpose_item<1>(c.in[I_WOUT] + (size_t)l * DM * DM, DM, DM, Wout, ga, scr, r, c.lane); continue; } r -= I_OUT;
        const int which = r / (NE * I_EXP); r -= which * (NE * I_EXP); const int e = r / I_EXP; r -= e * I_EXP;
        const size_t eoff = ((size_t)l * NE + e) * DM * DF;
        if (which == 0) transpose_item<2>(c.in[I_WGATE] + eoff, DM, DF, Wgu + (size_t)e * 2 * DF * DM, c.in[I_GFFN] + l * DM, scr, r, c.lane);
        else if (which == 1) transpose_item<3>(c.in[I_WUP] + eoff, DM, DF, Wgu + (size_t)e * 2 * DF * DM, c.in[I_GFFN] + l * DM, scr, r, c.lane);
        else transpose_item<1>(c.in[I_WDOWN] + eoff, DF, DM, Wd + (size_t)e * DM * DF, nullptr, scr, r, c.lane);
    }
    if (l == 0) {
        float* cosT = (float*)(c.ws + WS_ROPE); float* sinT = cosT + SEQ * 32;
        for (int i = blockIdx.x * 512 + c.tid; i < SEQ * 32; i += c.G * 512) {
            const int pos = i >> 5, f = i & 31;
            double r = 1.0; for (int k = 0; k < f; ++k) r *= 0.74989420933245582730;
            const float inv = (float)r; const float ang = (float)pos * inv;
            float sv, cv; sincos_acc(ang, sv, cv); cosT[i] = cv; sinT[i] = sv;
        }
    }
}
__device__ __forceinline__ void phase_norm1(const Ctx& c, int l) {
    const bool fin = (l == DEPTH);
    const unsigned short* inv = (const unsigned short*)(c.ws + WS_INV);
    const bf16_t* ye = (const bf16_t*)(c.ws + WS_ATT);
    bf16_t* xb = (bf16_t*)(c.ws + WS_XB); float* rs1 = (float*)(c.ws + WS_RS1);
    constexpr int TT = 2;
    for (int t2 = c.gw; t2 < MTOK / TT; t2 += c.NGW) {
        float v[TT][16]; unsigned myinv[TT];
#pragma unroll
        for (int tk = 0; tk < TT; ++tk) { const int tok = TT * t2 + tk;
            if (l == 0) { const f32x4* xr = (const f32x4*)(c.in[I_X] + (size_t)tok * DM) + 2 * c.lane;
#pragma unroll
                for (int j = 0; j < 2; ++j) { const f32x4 a = xr[128 * j], b = xr[128 * j + 1]; v[tk][8 * j] = a[0]; v[tk][8 * j + 1] = a[1]; v[tk][8 * j + 2] = a[2]; v[tk][8 * j + 3] = a[3]; v[tk][8 * j + 4] = b[0]; v[tk][8 * j + 5] = b[1]; v[tk][8 * j + 6] = b[2]; v[tk][8 * j + 7] = b[3]; }
            } else { const u32x4* xr = (const u32x4*)(xb + (size_t)tok * DM) + c.lane;
#pragma unroll
                for (int j = 0; j < 2; ++j) { const u32x4 q = xr[64 * j]; v[tk][8 * j] = bflo(q.x); v[tk][8 * j + 1] = bfhi(q.x); v[tk][8 * j + 2] = bflo(q.y); v[tk][8 * j + 3] = bfhi(q.y); v[tk][8 * j + 4] = bflo(q.z); v[tk][8 * j + 5] = bfhi(q.z); v[tk][8 * j + 6] = bflo(q.w); v[tk][8 * j + 7] = bfhi(q.w); } }
            myinv[tk] = (l > 0) ? (unsigned)inv[((size_t)(tok >> 12) * NE + (c.lane & 15)) * SEQ + (tok & (SEQ - 1))] : 0xFFFFu; }
        if (l > 0) {
#pragma unroll
            for (int tk = 0; tk < TT; ++tk) {
                const int tok = TT * t2 + tk, b = tok >> 12;
                unsigned long long mask = __ballot((c.lane < 16) && (myinv[tk] != 0xFFFFu));
                while (mask) {
                    const int e1 = __builtin_ctzll(mask); mask &= mask - 1;
                    const bool two = (mask != 0ull); const int e2 = two ? __builtin_ctzll(mask) : e1; if (two) mask &= mask - 1;
                    const unsigned c1 = (unsigned)__builtin_amdgcn_readlane((int)myinv[tk], e1), c2 = (unsigned)__builtin_amdgcn_readlane((int)myinv[tk], e2);
                    const u32x4* y1 = (const u32x4*)(ye + ((size_t)(b * NE + e1) * CAP + c1) * DM) + c.lane;
                    const u32x4* y2 = (const u32x4*)(ye + ((size_t)(b * NE + e2) * CAP + c2) * DM) + c.lane;
                    u32x4 w1[2], w2[2];
#pragma unroll
                    for (int j = 0; j < 2; ++j) { w1[j] = y1[64 * j]; w2[j] = y2[64 * j]; }
                    const float f2 = two ? 1.0f : 0.0f;
#pragma unroll
                    for (int j = 0; j < 2; ++j) {
                        v[tk][8 * j] += bflo(w1[j].x) + f2 * bflo(w2[j].x); v[tk][8 * j + 1] += bfhi(w1[j].x) + f2 * bfhi(w2[j].x);
                        v[tk][8 * j + 2] += bflo(w1[j].y) + f2 * bflo(w2[j].y); v[tk][8 * j + 3] += bfhi(w1[j].y) + f2 * bfhi(w2[j].y);
                        v[tk][8 * j + 4] += bflo(w1[j].z) + f2 * bflo(w2[j].z); v[tk][8 * j + 5] += bfhi(w1[j].z) + f2 * bfhi(w2[j].z);
                        v[tk][8 * j + 6] += bflo(w1[j].w) + f2 * bflo(w2[j].w); v[tk][8 * j + 7] += bfhi(w1[j].w) + f2 * bfhi(w2[j].w); }
                }
            }
        }
#pragma unroll
        for (int tk = 0; tk < TT; ++tk) {
            const int tok = TT * t2 + tk;
            float ss = 0.f;
#pragma unroll
            for (int i = 0; i < 16; ++i) ss += v[tk][i] * v[tk][i];
            const float rs = 1.0f / sqrtf(wave_sum(ss) * (1.0f / DM) + RMS_EPS);
            if (fin) {
                const f32x4* gf = (const f32x4*)c.in[I_GFINAL] + 2 * c.lane;
                f32x4* orow = (f32x4*)(c.out + (size_t)tok * DM) + 2 * c.lane;
#pragma unroll
                for (int j = 0; j < 2; ++j) { const f32x4 g0 = gf[128 * j], g1 = gf[128 * j + 1];
                    orow[128 * j] = (f32x4){v[tk][8 * j] * rs * g0[0], v[tk][8 * j + 1] * rs * g0[1], v[tk][8 * j + 2] * rs * g0[2], v[tk][8 * j + 3] * rs * g0[3]};
                    orow[128 * j + 1] = (f32x4){v[tk][8 * j + 4] * rs * g1[0], v[tk][8 * j + 5] * rs * g1[1], v[tk][8 * j + 6] * rs * g1[2], v[tk][8 * j + 7] * rs * g1[3]}; }
            } else {
                u32x4* xo = (u32x4*)(xb + (size_t)tok * DM) + c.lane;
#pragma unroll
                for (int j = 0; j < 2; ++j) { u32x4 w; w.x = pk2(v[tk][8 * j], v[tk][8 * j + 1]); w.y = pk2(v[tk][8 * j + 2], v[tk][8 * j + 3]); w.z = pk2(v[tk][8 * j + 4], v[tk][8 * j + 5]); w.w = pk2(v[tk][8 * j + 6], v[tk][8 * j + 7]); xo[64 * j] = w; }
                if (c.lane == 0) rs1[tok] = rs;
            }
        }
    }
}

typedef short s16x4 __attribute__((ext_vector_type(4)));
typedef float f32x16 __attribute__((ext_vector_type(16)));
constexpr int KROW = 144;
constexpr int ATT_NKMAX = 384;
constexpr int ATT_V_OFF = ATT_NKMAX * KROW;
constexpr float MASKED = -3.0e38f, M_INIT = -1.0e30f;
__device__ __forceinline__ float swap_max(float m) { auto rr = __builtin_amdgcn_permlane32_swap(__float_as_uint(m), __float_as_uint(m), false, false); return fmaxf(__uint_as_float(rr[0]), __uint_as_float(rr[1])); }
__device__ __forceinline__ float swap_sum(float m) { auto rr = __builtin_amdgcn_permlane32_swap(__float_as_uint(m), __float_as_uint(m), false, false); return __uint_as_float(rr[0]) + __uint_as_float(rr[1]); }
__device__ __forceinline__ s16x4 vtr(LAS const char* p) { typedef short v4i16_t __attribute__((ext_vector_type(4))); return __builtin_bit_cast(s16x4, __builtin_amdgcn_ds_read_tr16_b64_v4i16((LAS v4i16_t*)p)); }

constexpr float ATT_THR = 8.0f;
#ifndef ATT_STAGGER
#define ATT_STAGGER 12
#endif
struct AttnSt { LAS const char* kp; LAS const char* vp; int vhalf, absbase, n, r, h; bool edge; float m, lsum; };
template <int BLK> __device__ __forceinline__ void attn_kread(const AttnSt& st, bf16x8 (&kf)[4]) {
#pragma unroll
    for (int cc = 0; cc < 4; ++cc) kf[cc] = *(LAS const bf16x8*)(st.kp + BLK * 32 * KROW + cc * 32);
}
__device__ __forceinline__ void attn_qk(const bf16x8 (&qf)[4], const bf16x8 (&kf)[4], const AttnSt& st, f32x16& S) {
    const float ninit = -st.m;
#pragma unroll
    for (int i = 0; i < 16; ++i) S[i] = ninit;
#pragma unroll
    for (int cc = 0; cc < 4; ++cc) S = __builtin_amdgcn_mfma_f32_32x32x16_bf16(kf[cc], qf[cc], S, 0, 0, 0);
}
template <int NB, int BLK>
__device__ __forceinline__ void attn_blocks(const bf16x8 (&qf)[4], AttnSt& st, f32x16& S, f32x16 (&O)[2]) {
    if constexpr (BLK < NB) {
        bf16x8 vf[2][2], kf[4];
#pragma unroll
        for (int sx = 0; sx < 2; ++sx)
#pragma unroll
            for (int t = 0; t < 2; ++t) { LAS const char* vq = st.vp + t * st.vhalf + (BLK * 32 + 16 * sx) * 64; const s16x4 lo = vtr(vq), hi = vtr(vq + 8 * 64);
                vf[sx][t] = __builtin_shufflevector(lo, hi, 0, 1, 2, 3, 4, 5, 6, 7); }
        if constexpr (BLK + 1 < NB) attn_kread<BLK + 1>(st, kf);
        __builtin_amdgcn_sched_barrier(0);
        const int r = st.r, h = st.h;
        if (BLK == 0 || BLK == NB - 1 || st.edge) {
            int L = -(st.absbase + 32 * BLK) - 4 * h, U = st.n - 1 - st.absbase - 32 * BLK - 4 * h;
            if (BLK == 0) L = max(L, r - 4 * h);
            if (BLK == NB - 1) U = min(U, r - 4 * h);
#pragma unroll
            for (int i = 0; i < 16; ++i) { const int ci = (i & 3) + 8 * (i >> 2); S[i] = (ci >= L && ci <= U) ? S[i] : MASKED; }
        }
        float mloc = fmaxf(fmaxf(S[0], S[1]), S[2]);
#pragma unroll
        for (int i = 3; i < 15; i += 2) mloc = fmaxf(fmaxf(mloc, S[i]), S[i + 1]);
        mloc = fmaxf(mloc, S[15]);
        mloc = swap_max(mloc);
        if (BLK == 0) {
            const float d = (mloc < -1.0e37f) ? 0.f : mloc;
#pragma unroll
            for (int i = 0; i < 16; ++i) S[i] -= d;
            st.m = d;
        } else if (__builtin_amdgcn_ballot_w64(mloc > ATT_THR) != 0ull) {
            const float d = fmaxf(mloc, 0.f), al = __builtin_amdgcn_exp2f(-d);
#pragma unroll
            for (int i = 0; i < 16; ++i) S[i] -= d;
#pragma unroll
            for (int t = 0; t < 2; ++t)
#pragma unroll
                for (int i = 0; i < 16; ++i) O[t][i] *= al;
            st.lsum *= al; st.m += d;
        }
        float ps = 0.f;
#pragma unroll
        for (int i = 0; i < 16; ++i) { S[i] = __builtin_amdgcn_exp2f(S[i]); ps += S[i]; }
        st.lsum += ps;
        bf16x8 pf[2];
#pragma unroll
        for (int sx = 0; sx < 2; ++sx) {
            u32x4 pw; pw.x = cvt_pk_bf16(S[8 * sx], S[8 * sx + 1]); pw.y = cvt_pk_bf16(S[8 * sx + 2], S[8 * sx + 3]); pw.z = cvt_pk_bf16(S[8 * sx + 4], S[8 * sx + 5]); pw.w = cvt_pk_bf16(S[8 * sx + 6], S[8 * sx + 7]);
            pf[sx] = __builtin_bit_cast(bf16x8, pw); }
        __builtin_amdgcn_s_setprio(1);
        if constexpr (BLK + 1 < NB) attn_qk(qf, kf, st, S);
#pragma unroll
        for (int sx = 0; sx < 2; ++sx)
#pragma unroll
            for (int t = 0; t < 2; ++t) O[t] = __builtin_amdgcn_mfma_f32_32x32x16_bf16(vf[sx][t], pf[sx], O[t], 0, 0, 0);
        __builtin_amdgcn_s_setprio(0);
        attn_blocks<NB, BLK + 1>(qf, st, S, O);
    }
}
template <int NB>
__device__ __forceinline__ void attn_core(const bf16x8 (&qf)[4], LAS const char* Kb, LAS const char* Vb, int vhalf, int kb0, int absbase, int n, int lane,
                                          f32x16 (&O)[2], float& m_out, float& l_out) {
    AttnSt st; st.r = lane & 31; st.h = lane >> 5; st.vhalf = vhalf; st.absbase = absbase; st.n = n;
    st.kp = Kb + (kb0 * 32 + st.r) * KROW + st.h * 16;
    st.vp = Vb + (kb0 * 32 + 4 * st.h + ((lane & 15) >> 2)) * 64 + ((lane >> 4) & 1) * 32 + (lane & 3) * 8;
    st.edge = (absbase < 0) || (absbase + 32 * NB > n);
    st.m = 0.f; st.lsum = 0.f;
#pragma unroll
    for (int t = 0; t < 2; ++t)
#pragma unroll
        for (int i = 0; i < 16; ++i) O[t][i] = 0.f;
    f32x16 S; bf16x8 kf0[4];
    if (__builtin_amdgcn_readfirstlane(threadIdx.x >> 8)) __builtin_amdgcn_s_sleep(ATT_STAGGER);
    attn_kread<0>(st, kf0);
    attn_qk(qf, kf0, st, S);
    attn_blocks<NB, 0>(qf, st, S, O);
    m_out = st.m; l_out = swap_sum(st.lsum);
}
__device__ __forceinline__ void attn_store(const f32x16 (&O)[2], float scale, bf16_t* dst, int h) {
#pragma unroll
    for (int t = 0; t < 2; ++t)
#pragma unroll
        for (int gp = 0; gp < 2; ++gp) { const int g0 = 2 * gp, g1 = 2 * gp + 1;
            unsigned ax = cvt_pk_bf16(O[t][4 * g0] * scale, O[t][4 * g0 + 1] * scale), ay = cvt_pk_bf16(O[t][4 * g0 + 2] * scale, O[t][4 * g0 + 3] * scale);
            unsigned bx = cvt_pk_bf16(O[t][4 * g1] * scale, O[t][4 * g1 + 1] * scale), by = cvt_pk_bf16(O[t][4 * g1 + 2] * scale, O[t][4 * g1 + 3] * scale);
            { auto rr = __builtin_amdgcn_permlane32_swap(ax, bx, false, false); ax = rr[0]; bx = rr[1]; }
            { auto rr = __builtin_amdgcn_permlane32_swap(ay, by, false, false); ay = rr[0]; by = rr[1]; }
            u32x4 w; w.x = ax; w.y = ay; w.z = bx; w.w = by;
            *(u32x4*)(dst + 32 * t + 16 * gp + 8 * h) = w; }
}
constexpr size_t ATT_P_STRIDE = (size_t)MTOK * 512;
struct AJob { int b, head, pat, d, cls, qt, n; };
__device__ __forceinline__ AJob a_decode(int job, int G) { AJob j; int j48, bh;
    if (G == 256) { const int x = job & 7, jx = job >> 3; j48 = jx % 48; bh = (jx / 48) * 8 + x; } else { j48 = job % 48; bh = job / 48; }
    j.head = bh & 7; j.b = bh >> 3; j.pat = j48 >> 4; const int sub = j48 & 15;
    if (j.pat == 0) { j.d = 1; j.cls = 0; j.qt = sub; } else if (j.pat == 1) { j.d = 4; j.cls = sub & 3; j.qt = sub >> 2; } else { j.d = 16; j.cls = sub; j.qt = 0; }
    j.n = SEQ / j.d; return j; }
__device__ __forceinline__ void phase_attn_mfma(const Ctx& c, int l) {
    const bf16_t* proj = (const bf16_t*)(c.ws + WS_PROJ);
    bf16_t* oP = (bf16_t*)(c.ws + WS_ATT); float* lse = (float*)(c.ws + WS_LSE);
    LAS char* Kl = (LAS char*)c.lds; LAS char* Vl = (LAS char*)c.lds + ATT_V_OFF;
    const int tid = c.tid, lane = c.lane, wave = c.wave, r = lane & 31, h = lane >> 5;
    {
        constexpr int NJ = BATCH * 8 * 48;
        u32x4 kreg[6], vreg[6]; bf16x8 qf[4];
#define A_LOAD(job_) do { const AJob j_ = a_decode(job_, c.G); const int kabs0_ = 256 * j_.qt - 64; const bf16_t* pb_ = proj + (size_t)j_.b * SEQ * INW; \
        _Pragma("unroll") for (int it = 0; it < 6; ++it) { const int pi = tid + 512 * it, key = pi >> 3, part = pi & 7, jk = kabs0_ + key; const bool ok = (jk >= 0) && (jk < j_.n); \
            const bf16_t* src = pb_ + (size_t)(j_.cls + j_.d * (ok ? jk : 0)) * INW + j_.head * 64 + part * 8; \
            kreg[it] = ok ? *(const u32x4*)(src + 512) : (u32x4){0u, 0u, 0u, 0u}; vreg[it] = ok ? *(const u32x4*)(src + 1024) : (u32x4){0u, 0u, 0u, 0u}; } } while (0)
#define A_QLOAD(job_) do { const AJob j_ = a_decode(job_, c.G); const int qtok_ = j_.cls + j_.d * (256 * j_.qt + 32 * wave + r); \
        const bf16_t* qp_ = proj + ((size_t)j_.b * SEQ + qtok_) * INW + j_.head * 64 + 8 * h; \
        _Pragma("unroll") for (int cc = 0; cc < 4; ++cc) qf[cc] = *(const bf16x8*)(qp_ + 16 * cc); } while (0)
        int job = blockIdx.x;
        if (job < NJ) { A_LOAD(job); A_QLOAD(job); }
        for (; job < NJ; job += c.G) {
            const AJob j = a_decode(job, c.G);
#pragma unroll
            for (int it = 0; it < 6; ++it) { const int pi = tid + 512 * it, key = pi >> 3, part = pi & 7;
                *(LAS u32x4*)(Kl + key * KROW + part * 16) = kreg[it];
                *(LAS u32x4*)(Vl + (part >> 2) * (ATT_NKMAX * 64) + key * 64 + (part & 3) * 16) = vreg[it]; }
            __syncthreads();
            if (job + c.G < NJ) A_LOAD(job + c.G);
            f32x16 O[2]; float m, ls;
            attn_core<5>(qf, Kl, Vl, ATT_NKMAX * 64, wave, 256 * j.qt + 32 * wave - 64, j.n, lane, O, m, ls);
            if (job + c.G < NJ) A_QLOAD(job + c.G);
            const size_t trow = (size_t)j.b * SEQ + j.cls + j.d * (256 * j.qt + 32 * wave + r);
            attn_store(O, 1.0f / ls, oP + (size_t)j.pat * ATT_P_STRIDE + trow * 512 + j.head * 64, h);
            if (h == 0) lse[((size_t)j.pat * MTOK + trow) * 8 + j.head] = m + __builtin_amdgcn_logf(ls);
            __syncthreads();
        }
#undef A_LOAD
#undef A_QLOAD
    }
    {
        constexpr int NJ = BATCH * 2 * 64;
        u32x4 kreg[5], vreg[5]; bf16x8 qf[4];
#define B_DEC(job_, tt_, kvh_, b_) int tt_, kvh_, b_; do { if (c.G == 256) { const int x_ = (job_) & 7, jx_ = (job_) >> 3; tt_ = jx_ & 63; const int pr_ = (jx_ >> 6) * 8 + x_; kvh_ = pr_ & 1; b_ = pr_ >> 1; } else { tt_ = (job_) & 63; kvh_ = ((job_) >> 6) & 1; b_ = (job_) >> 7; } } while (0)
#define B_LOAD(job_) do { B_DEC(job_, tt_, kvh_, b_); const int kabs0_ = 64 * tt_ - 128; const bf16_t* pb_ = proj + (size_t)b_ * SEQ * INW; \
        _Pragma("unroll") for (int it = 0; it < 5; ++it) { const int pi = tid + 512 * it, key = pi >> 3, part = pi & 7, jk = kabs0_ + key; const bool ok = (jk >= 0) && (jk < SEQ); \
            const bf16_t* src = pb_ + (size_t)(ok ? jk : 0) * INW + kvh_ * 64 + part * 8; \
            kreg[it] = ok ? *(const u32x4*)(src + 2048) : (u32x4){0u, 0u, 0u, 0u}; vreg[it] = ok ? *(const u32x4*)(src + 2176) : (u32x4){0u, 0u, 0u, 0u}; } } while (0)
#define B_QLOAD(job_) do { B_DEC(job_, tt_, kvh_, b_); const int g_ = kvh_ * 4 + (wave >> 1), qtok_ = 64 * tt_ + 32 * (wave & 1) + r; \
        const bf16_t* qp_ = proj + ((size_t)b_ * SEQ + qtok_) * INW + 1536 + g_ * 64 + 8 * h; \
        _Pragma("unroll") for (int cc = 0; cc < 4; ++cc) qf[cc] = *(const bf16x8*)(qp_ + 16 * cc); } while (0)
        int job = blockIdx.x;
        if (job < NJ) { B_LOAD(job); B_QLOAD(job); }
        for (; job < NJ; job += c.G) {
            B_DEC(job, tt, kvh, b);
            const int g = kvh * 4 + (wave >> 1), qtok = 64 * tt + 32 * (wave & 1) + r;
#pragma unroll
            for (int it = 0; it < 5; ++it) { const int pi = tid + 512 * it, key = pi >> 3, part = pi & 7;
                *(LAS u32x4*)(Kl + key * KROW + part * 16) = kreg[it];
                *(LAS u32x4*)(Vl + (part >> 2) * (ATT_NKMAX * 64) + key * 64 + (part & 3) * 16) = vreg[it]; }
            __syncthreads();
            if (job + c.G < NJ) B_LOAD(job + c.G);
            f32x16 O[2]; float m, ls;
            attn_core<9>(qf, Kl, Vl, ATT_NKMAX * 64, wave & 1, 64 * tt + 32 * (wave & 1) - 128, SEQ, lane, O, m, ls);
            if (job + c.G < NJ) B_QLOAD(job + c.G);
            const float s2 = c.in[I_SINK][l * 8 + g] * LOG2E, mf = fmaxf(m, s2), al = __builtin_amdgcn_exp2f(m - mf);
            const float lt = ls * al + __builtin_amdgcn_exp2f(s2 - mf);
            attn_store(O, al / lt, oP + 3 * ATT_P_STRIDE + ((size_t)b * SEQ + qtok) * 512 + g * 64, h);
            __syncthreads();
        }
#undef B_LOAD
#undef B_QLOAD
#undef B_DEC
    }
}
__device__ __forceinline__ void phase_merge_norm(const Ctx& c) {
    const bf16_t* oP = (const bf16_t*)(c.ws + WS_ATT); const float* lse = (const float*)(c.ws + WS_LSE); bf16_t* mix = (bf16_t*)(c.ws + WS_ACT);
    const int lane = c.lane, head = lane >> 3;
    constexpr int TT = 2;
    for (int t2 = c.gw; t2 < MTOK / TT; t2 += c.NGW) {
        float lq[TT][3]; u32x4 aq[TT][4];
#pragma unroll
        for (int tk = 0; tk < TT; ++tk) { const int tok = TT * t2 + tk;
#pragma unroll
            for (int p = 0; p < 3; ++p) lq[tk][p] = lse[((size_t)p * MTOK + tok) * 8 + head];
#pragma unroll
            for (int p = 0; p < 4; ++p) aq[tk][p] = *((const u32x4*)(oP + (size_t)p * ATT_P_STRIDE + (size_t)tok * 512) + lane); }
#pragma unroll
        for (int tk = 0; tk < TT; ++tk) {
            const int tok = TT * t2 + tk;
            const float l0 = lq[tk][0], l1 = lq[tk][1], l2 = lq[tk][2];
            const float mx = fmaxf(l0, fmaxf(l1, l2));
            float w0 = __builtin_amdgcn_exp2f(l0 - mx), w1 = __builtin_amdgcn_exp2f(l1 - mx), w2 = __builtin_amdgcn_exp2f(l2 - mx);
            const float iw = 1.0f / (w0 + w1 + w2); w0 *= iw; w1 *= iw; w2 *= iw;
            const u32x4 a0 = aq[tk][0], a1 = aq[tk][1], a2 = aq[tk][2], bq = aq[tk][3];
            const unsigned x0[4] = {a0.x, a0.y, a0.z, a0.w}, x1[4] = {a1.x, a1.y, a1.z, a1.w}, x2[4] = {a2.x, a2.y, a2.z, a2.w}, xb[4] = {bq.x, bq.y, bq.z, bq.w};
            float av[8], bv[8]; float sa = 0.f, sb = 0.f;
#pragma unroll
            for (int i = 0; i < 4; ++i) { av[2 * i] = w0 * bflo(x0[i]) + w1 * bflo(x1[i]) + w2 * bflo(x2[i]); av[2 * i + 1] = w0 * bfhi(x0[i]) + w1 * bfhi(x1[i]) + w2 * bfhi(x2[i]);
                bv[2 * i] = bflo(xb[i]); bv[2 * i + 1] = bfhi(xb[i]); }
#pragma unroll
            for (int i = 0; i < 8; ++i) { sa += av[i] * av[i]; sb += bv[i] * bv[i]; }
            const float ra = 1.0f / sqrtf(wave_sum(sa) * (1.0f / 512) + RMS_EPS), rb = 1.0f / sqrtf(wave_sum(sb) * (1.0f / 512) + RMS_EPS);
            u32x4 oa, ob; oa.x = pk2(av[0] * ra, av[1] * ra); oa.y = pk2(av[2] * ra, av[3] * ra); oa.z = pk2(av[4] * ra, av[5] * ra); oa.w = pk2(av[6] * ra, av[7] * ra);
            ob.x = pk2(bv[0] * rb, bv[1] * rb); ob.y = pk2(bv[2] * rb, bv[3] * rb); ob.z = pk2(bv[4] * rb, bv[5] * rb); ob.w = pk2(bv[6] * rb, bv[7] * rb);
            *((u32x4*)(mix + (size_t)tok * DM) + lane) = oa; *((u32x4*)(mix + (size_t)tok * DM + 512) + lane) = ob;
        }
    }
}

__device__ __forceinline__ void phase_norm2_router(const Ctx& c, int l) {
    LAS u32x4* wh = (LAS u32x4*)c.lds; LAS u32x4* wl = wh + 32 * 64;
    const GAS float* wsrc = c.in[I_WROUTER] + (size_t)l * DM * NE; const GAS float* gf = c.in[I_GFFN] + l * DM;
    for (int i = c.tid; i < 32 * 64; i += 512) { const int ks = i >> 6, ln = i & 63, e = ln & 15, g = ln >> 4;
        unsigned hi[8], lo[8];
#pragma unroll
        for (int j = 0; j < 8; ++j) { const int k = 32 * ks + 8 * g + j; const float w = wsrc[k * NE + e] * gf[k]; hi[j] = f2bf(w); lo[j] = f2bf(w - bflo(hi[j])); }
        wh[i] = (u32x4){hi[0] | (hi[1] << 16), hi[2] | (hi[3] << 16), hi[4] | (hi[5] << 16), hi[6] | (hi[7] << 16)};
        wl[i] = (u32x4){lo[0] | (lo[1] << 16), lo[2] | (lo[3] << 16), lo[4] | (lo[5] << 16), lo[6] | (lo[7] << 16)}; }
    __syncthreads();
    const bf16_t* xb = (const bf16_t*)(c.ws + WS_XB); float* rs2 = (float*)(c.ws + WS_RS2); float* aff = (float*)(c.ws + WS_AFF);
    const int lane = c.lane, e = lane & 15, g = lane >> 4;
    for (int tile = c.gw; tile < MTOK / 16; tile += c.NGW) {
        const int tok0 = tile * 16;
        const u32x4* xr = (const u32x4*)(xb + (size_t)(tok0 + e) * DM) + g;
        f32x4 L = {0.f, 0.f, 0.f, 0.f}, Q = {0.f, 0.f, 0.f, 0.f};
        int wlane = lane; asm volatile("" : "+v"(wlane));
#pragma unroll
        for (int kb = 0; kb < 32; kb += 8) {
            u32x4 xv[8];
#pragma unroll
            for (int i = 0; i < 8; ++i) xv[i] = xr[4 * (kb + i)];
#pragma unroll
            for (int i = 0; i < 8; ++i) { const bf16x8 a = __builtin_bit_cast(bf16x8, xv[i]);
                const u32x4 bh = wh[(kb + i) * 64 + wlane], bl = wl[(kb + i) * 64 + wlane];
                L = __builtin_amdgcn_mfma_f32_16x16x32_bf16(a, __builtin_bit_cast(bf16x8, bh), L, 0, 0, 0);
                L = __builtin_amdgcn_mfma_f32_16x16x32_bf16(a, __builtin_bit_cast(bf16x8, bl), L, 0, 0, 0);
                Q = __builtin_amdgcn_mfma_f32_16x16x32_bf16(a, a, Q, 0, 0, 0); }
        }
        float lg[4];
        const float q0 = Q[0], q1 = Q[1], q2 = Q[2], q3 = Q[3];
        const float s0 = __builtin_bit_cast(float, __builtin_amdgcn_ds_bpermute((16 * g + 4 * g + 0) << 2, __builtin_bit_cast(int, q0)));
        const float s1 = __builtin_bit_cast(float, __builtin_amdgcn_ds_bpermute((16 * g + 4 * g + 1) << 2, __builtin_bit_cast(int, q1)));
        const float s2 = __builtin_bit_cast(float, __builtin_amdgcn_ds_bpermute((16 * g + 4 * g + 2) << 2, __builtin_bit_cast(int, q2)));
        const float s3 = __builtin_bit_cast(float, __builtin_amdgcn_ds_bpermute((16 * g + 4 * g + 3) << 2, __builtin_bit_cast(int, q3)));
        f32x4 rsv; rsv[0] = 1.0f / sqrtf(s0 * (1.0f / DM) + RMS_EPS); rsv[1] = 1.0f / sqrtf(s1 * (1.0f / DM) + RMS_EPS); rsv[2] = 1.0f / sqrtf(s2 * (1.0f / DM) + RMS_EPS); rsv[3] = 1.0f / sqrtf(s3 * (1.0f / DM) + RMS_EPS);
        if (e == 0) *(f32x4*)(rs2 + tok0 + 4 * g) = rsv;
        f32x4 av;
#pragma unroll
        for (int r = 0; r < 4; ++r) { lg[r] = L[r] * rsv[r];
            float mx = lg[r];
            mx = fmaxf(mx, __shfl_xor(mx, 1)); mx = fmaxf(mx, __shfl_xor(mx, 2)); mx = fmaxf(mx, __shfl_xor(mx, 4)); mx = fmaxf(mx, __shfl_xor(mx, 8));
            const float ex = expf(lg[r] - mx);
            float sm = ex; sm += __shfl_xor(sm, 1); sm += __shfl_xor(sm, 2); sm += __shfl_xor(sm, 4); sm += __shfl_xor(sm, 8);
            av[r] = ex / sm; }
        *(f32x4*)(aff + ((size_t)(tok0 >> 12) * NE + e) * SEQ + (tok0 & (SEQ - 1)) + 4 * g) = av;
    }
    __syncthreads();
}

__device__ __forceinline__ void phase_topk(const Ctx& c) {
    LAS unsigned* hist = (LAS unsigned*)c.lds;
    LAS unsigned* misc = hist + 256;
    const float* aff = (const float*)(c.ws + WS_AFF);
    int* idx = (int*)(c.ws + WS_IDX); float* gate = (float*)(c.ws + WS_GATE); unsigned short* inv = (unsigned short*)(c.ws + WS_INV);
    const float* rs2 = (const float*)(c.ws + WS_RS2); float* rss = (float*)(c.ws + WS_RSS);
    const int tid = c.tid, lane = c.lane, wave = c.wave;
    for (int u = blockIdx.x; u < BATCH * NE; u += c.G) {
        const int b = u / NE, e = u % NE;
        const f32x4* ap = (const f32x4*)(aff + (size_t)u * SEQ) + 2 * tid;
        const f32x4 a0 = ap[0], a1 = ap[1];
        const float av[8] = {a0[0], a0[1], a0[2], a0[3], a1[0], a1[1], a1[2], a1[3]};
        unsigned key[8];
#pragma unroll
        for (int i = 0; i < 8; ++i) key[i] = __float_as_uint(av[i]);
        unsigned prefix = 0u, kneed = CAP;
#pragma unroll
        for (int pass = 0; pass < 4; ++pass) {
            const int shift = 24 - 8 * pass;
            if (tid < 256) hist[tid] = 0u;
            __syncthreads();
#pragma unroll
            for (int i = 0; i < 8; ++i) { const bool match = (pass == 0) ? true : ((key[i] >> (shift + 8)) == prefix); if (match) __hip_atomic_fetch_add(&hist[(key[i] >> shift) & 255u], 1u, __ATOMIC_RELAXED, __HIP_MEMORY_SCOPE_WORKGROUP); }
            __syncthreads();
            if (wave == 0) {
                unsigned hb[4]; unsigned s4 = 0u;
#pragma unroll
                for (int i = 0; i < 4; ++i) { hb[i] = hist[4 * lane + i]; s4 += hb[i]; }
                unsigned suf = s4;
#pragma unroll
                for (int off = 1; off < 64; off <<= 1) { const unsigned t = __shfl_down(suf, off); if (lane + off < 64) suf += t; }
                unsigned cum = suf - s4;
#pragma unroll
                for (int i = 3; i >= 0; --i) { if (cum < kneed && kneed <= cum + hb[i]) { misc[0] = 4u * lane + i; misc[1] = kneed - cum; } cum += hb[i]; }
            }
            __syncthreads();
            prefix = (prefix << 8) | misc[0]; kneed = misc[1];
            __syncthreads();
        }
        const unsigned T = prefix;
        unsigned cg = 0u, ce = 0u;
#pragma unroll
        for (int i = 0; i < 8; ++i) { cg += (key[i] > T) ? 1u : 0u; ce += (key[i] == T) ? 1u : 0u; }
        const unsigned packed = cg | (ce << 16);
        unsigned inc = packed;
#pragma unroll
        for (int off = 1; off < 64; off <<= 1) { const unsigned t = __shfl_up(inc, off); if (lane >= off) inc += t; }
        if (lane == 63) misc[8 + wave] = inc;
        __syncthreads();
        unsigned wbase = 0u;
#pragma unroll
        for (int w = 0; w < 8; ++w) if (w < wave) wbase += misc[8 + w];
        const unsigned excl = wbase + inc - packed;
        unsigned gbefore = excl & 0xffffu, ebefore = excl >> 16;
#pragma unroll
        for (int i = 0; i < 8; ++i) {
            const int s = tid * 8 + i;
            const bool gt = key[i] > T, eq = key[i] == T;
            const bool sel = gt || (eq && ebefore < kneed);
            const unsigned slot = gbefore + (ebefore < kneed ? ebefore : kneed);
            if (sel) { idx[u * CAP + slot] = s; gate[u * CAP + slot] = av[i]; rss[u * CAP + slot] = rs2[b * SEQ + s]; }
            inv[(size_t)u * SEQ + s] = sel ? (unsigned short)slot : (unsigned short)0xFFFFu;
            gbefore += gt ? 1u : 0u; ebefore += eq ? 1u : 0u;
        }
        __syncthreads();
    }
}


__device__ __forceinline__ void refresh(Ctx& c, const Params& a) {
    int t = threadIdx.x; asm volatile("" : "+v"(t)); c.tid = t; c.lane = t & 63;
    unsigned wl = (unsigned)(uintptr_t)a.ws, wh = (unsigned)((uintptr_t)a.ws >> 32); asm volatile("" : "+v"(wl), "+v"(wh));
    wl = (unsigned)__builtin_amdgcn_readfirstlane((int)wl); wh = (unsigned)__builtin_amdgcn_readfirstlane((int)wh);
    c.ws = (GAS unsigned char*)(((uintptr_t)wh << 32) | (uintptr_t)wl);
    const uintptr_t kp = (uintptr_t)__builtin_amdgcn_kernarg_segment_ptr();
    unsigned kl = (unsigned)kp, kh = (unsigned)(kp >> 32); asm volatile("" : "+v"(kl), "+v"(kh));
    kl = (unsigned)__builtin_amdgcn_readfirstlane((int)kl); kh = (unsigned)__builtin_amdgcn_readfirstlane((int)kh);
    c.in = (const GAS float* const GAS*)(((uintptr_t)kh << 32) | (uintptr_t)kl);
}
__global__ void __launch_bounds__(512, 2) fwd_kernel(Params args) {
    extern __shared__ __attribute__((aligned(16))) unsigned char lds_raw[];
    Ctx c;
    c.lds = (LAS unsigned char*)lds_raw;
    c.tid = threadIdx.x; c.lane = c.tid & 63; c.wave = __builtin_amdgcn_readfirstlane(c.tid >> 6);
    c.G = gridDim.x; c.gw = blockIdx.x * 8 + c.wave; c.NGW = c.G * 8;
    c.out = (GAS float*)args.out; c.ws = (GAS unsigned char*)args.ws;
    volatile LAS unsigned* MISC = (volatile LAS unsigned*)(c.lds + MISC_OFF);
    if (c.tid < 16) MISC[c.tid] = 0u;
    __syncthreads();
    const int lo = args.ph_lo, hi = args.ph_hi;
    XcdBarrier bar; bar.bar = (unsigned*)(c.ws + WS_CTL); bar.x = 0; bar.st = MISC + 8;
    if (hi - lo > 1) bar = xcd_barrier_post((unsigned*)(c.ws + WS_CTL), MISC + 8);
#define IN(k) (lo <= (k) && (k) < hi)
#define SEAM(k) do { if (IN(k) && IN((k) + 1)) xcd_barrier(bar); } while (0)

    for (int l = 0; l < DEPTH; ++l) {
        const int p0 = l * NPH;
        if (IN(p0 + 0)) { refresh(c, args); phase_weights(c, l); phase_norm1(c, l); }
        SEAM(p0 + 0);
        if (IN(p0 + 1)) { refresh(c, args);
            pg8::PlainAB ab{(const bf16_t*)(c.ws + WS_XB), (const bf16_t*)(c.ws + WS_WIN), DM};
            pg8::StaticOrder S; S.init(MTOK, INW, c.G, (int)blockIdx.x);
            pg8::EpiRope E{(bf16_t*)(c.ws + WS_PROJ), (const float*)(c.ws + WS_ROPE), (const float*)(c.ws + WS_ROPE) + SEQ * 32, (const float*)(c.ws + WS_RS1)};
            pg8::gemm_phase<pg8::EpiRope, pg8::StaticOrder, pg8::PlainAB>(c.lds, ab, S, E);
        }
        SEAM(p0 + 1);
        if (IN(p0 + 2)) { refresh(c, args); phase_attn_mfma(c, l); }
        SEAM(p0 + 2);
        if (IN(p0 + 3)) { refresh(c, args); phase_merge_norm(c); }
        SEAM(p0 + 3);
        if (IN(p0 + 4)) { refresh(c, args);
            pg8::PlainAB ab{(const bf16_t*)(c.ws + WS_ACT), (const bf16_t*)(c.ws + WS_WOUT), DM};
            pg8::StaticOrder S; S.init(MTOK, DM, c.G, (int)blockIdx.x);
            pg8::EpiResid E{(bf16_t*)(c.ws + WS_XB)};
            pg8::gemm_phase<pg8::EpiResid, pg8::StaticOrder, pg8::PlainAB>(c.lds, ab, S, E);
        }
        SEAM(p0 + 4);
        if (IN(p0 + 5)) { refresh(c, args); phase_norm2_router(c, l); }
        SEAM(p0 + 5);
        if (IN(p0 + 6)) { refresh(c, args); phase_topk(c); }
        SEAM(p0 + 6);
        if (IN(p0 + 7)) { refresh(c, args);
            pg8::GatherAB ab{(const bf16_t*)(c.ws + WS_XB), (const int*)(c.ws + WS_IDX), (const bf16_t*)(c.ws + WS_WGU), DM, 2 * DF};
            pg8::GroupOrder<3> S; S.init(c.G, (int)blockIdx.x);
            pg8::EpiSwiglu E{(bf16_t*)(c.ws + WS_PROJ), (const float*)(c.ws + WS_RSS)};
            pg8::gemm_phase<pg8::EpiSwiglu, pg8::GroupOrder<3>, pg8::GatherAB>(c.lds, ab, S, E);
        }
        SEAM(p0 + 7);
        if (IN(p0 + 8)) { refresh(c, args);
            pg8::GroupAB ab{(const bf16_t*)(c.ws + WS_PROJ), (const bf16_t*)(c.ws + WS_WD), DF, DM};
            pg8::GroupOrder<2, true> S; S.init(c.G, (int)blockIdx.x);
            pg8::EpiDown E{(bf16_t*)(c.ws + WS_ATT), (const float*)(c.ws + WS_GATE)};
            pg8::gemm_phase<pg8::EpiDown, pg8::GroupOrder<2, true>, pg8::GroupAB>(c.lds, ab, S, E);
        }
        SEAM(p0 + 8);
    }
    if (IN(DEPTH * NPH)) { refresh(c, args); phase_norm1(c, DEPTH); }
#undef IN
#undef SEAM
}

extern "C" void kernel_launch(void* const* d_in, const int* in_sizes, int n_in, void* d_out, int out_size, void* d_ws, size_t ws_size, hipStream_t stream) {
    static int grid = 0;
    if (grid == 0) {
        if (n_in != 13 || out_size != MTOK * DM || ws_size < WS_END) { fprintf(stderr, "kernel_launch: unexpected shapes (n_in %d, out %d, ws %zu)\n", n_in, out_size, ws_size); grid = -1; return; }
        int dev = 0, cus = 0, per_cu = 0;
        if (hipGetDevice(&dev) != hipSuccess || hipDeviceGetAttribute(&cus, hipDeviceAttributeMultiprocessorCount, dev) != hipSuccess) { grid = -1; return; }
        if (hipFuncSetAttribute((const void*)fwd_kernel, hipFuncAttributeMaxDynamicSharedMemorySize, LDS_BYTES) != hipSuccess) { fprintf(stderr, "kernel_launch: hipFuncSetAttribute failed\n"); grid = -1; return; }
        if (hipOccupancyMaxActiveBlocksPerMultiprocessor(&per_cu, (const void*)fwd_kernel, 512, LDS_BYTES) != hipSuccess || per_cu < 1) fprintf(stderr, "kernel_launch: occupancy query reports %d\n", per_cu);
        (void)hipGetLastError();
        grid = cus;
    }
    if (grid < 0) return;
    (void)hipMemsetAsync((char*)d_ws + WS_CTL, 0, CTL_ZERO_BYTES, stream);
    Params p{};
    for (int i = 0; i < 13; ++i) p.in[i] = (const float*)d_in[i];
    p.out = (float*)d_out; p.ws = (unsigned char*)d_ws;
    p.ph_lo = 0; p.ph_hi = PH_TOTAL;
    hipLaunchKernelGGL(fwd_kernel, dim3(grid), dim3(512), LDS_BYTES, stream, p);
}
```

```cpp
#include <hip/hip_runtime.h>
#include <cstdio>
#include <cstdint>

constexpr int BATCH = 16, SEQ = 4096, DM = 1024, DEPTH = 4, HD = 64;
constexpr int MTOK = BATCH * SEQ;
constexpr int INW = 2304;
constexpr int NE = 16, DF = 1024, CAP = 512;
constexpr float RMS_EPS = 1e-6f;
constexpr float LOG2E = 1.4426950408889634f;
constexpr float QSCALE = 0.125f * LOG2E;

constexpr size_t MiB = 1u << 20;
constexpr size_t WS_CTL = 0, CTL_ZERO_BYTES = 64 * 1024;
constexpr size_t WS_ROPE = 1 * MiB;
constexpr size_t WS_AFF = 2 * MiB;
constexpr size_t WS_IDX = 6 * MiB;
constexpr size_t WS_GATE = 7 * MiB;
constexpr size_t WS_INV = 8 * MiB;
constexpr size_t WS_LSE = 10 * MiB;
constexpr size_t WS_RS1 = 6 * MiB + 512 * 1024;
constexpr size_t WS_RS2 = 6 * MiB + 768 * 1024;
constexpr size_t WS_RSS = 7 * MiB + 512 * 1024;
constexpr size_t WS_WIN = 16 * MiB;
constexpr size_t WS_WOUT = 21 * MiB;
constexpr size_t WS_WGU = 24 * MiB;
constexpr size_t WS_WD = 88 * MiB;
constexpr size_t WS_ACT = 120 * MiB;
constexpr size_t WS_PROJ = 248 * MiB;
constexpr size_t WS_ATT = 536 * MiB;
constexpr size_t WS_XB = 792 * MiB;
constexpr size_t WS_END = 920 * MiB;

constexpr int LDS_BYTES = 147456;
constexpr int RING_BYTES = 131072;
constexpr int MISC_OFF = RING_BYTES;

typedef float f32x2 __attribute__((ext_vector_type(2)));
#define GAS __attribute__((address_space(1)))
#define LAS __attribute__((address_space(3)))
typedef unsigned short bf16_t;
typedef short bf16x8 __attribute__((ext_vector_type(8)));
typedef float f32x4 __attribute__((ext_vector_type(4)));
typedef unsigned u32x4 __attribute__((ext_vector_type(4)));
typedef unsigned u32x2 __attribute__((ext_vector_type(2)));

__device__ __forceinline__ unsigned f2bf(float f) { unsigned u = __builtin_bit_cast(unsigned, f); return (u + 0x7fffu + ((u >> 16) & 1u)) >> 16; }
__device__ __forceinline__ unsigned pk2(float lo, float hi) { return f2bf(lo) | (f2bf(hi) << 16); }
__device__ __forceinline__ float bflo(unsigned w) { return __builtin_bit_cast(float, w << 16); }
__device__ __forceinline__ float bfhi(unsigned w) { return __builtin_bit_cast(float, w & 0xffff0000u); }
__device__ __forceinline__ unsigned cvt_pk_bf16(float lo, float hi) { unsigned r; asm volatile("v_cvt_pk_bf16_f32 %0, %1, %2" : "=v"(r) : "v"(lo), "v"(hi)); return r; }
__device__ __forceinline__ float wave_sum(float v) {
#pragma unroll
    for (int o = 1; o < 64; o <<= 1) v += __shfl_xor(v, o);
    return v;
}
#define LDS_WAIT() asm volatile("s_waitcnt lgkmcnt(0)" ::: "memory")
#define GAS __attribute__((address_space(1)))

#define XB_TMO      128
#define XB_XCNT(j)  (256  + 64 * (j))
#define XB_XSUB(j)  (1280 + 64 * (j))
#define XB_XGEN(j)  (2304 + 64 * (j))
#define XB_TOP      3328
#define XB_TOPGEN   3392
#define XCD_BAR_WORDS 3456
#define XB_SPIN_CAP (1u << 23)

__device__ __forceinline__ unsigned xb_ld(unsigned* p)              { return __hip_atomic_load(p, __ATOMIC_RELAXED, __HIP_MEMORY_SCOPE_AGENT); }
__device__ __forceinline__ unsigned xb_add(unsigned* p, unsigned v) { return __hip_atomic_fetch_add(p, v, __ATOMIC_RELAXED, __HIP_MEMORY_SCOPE_AGENT); }
__device__ __forceinline__ unsigned xb_xcc_id() { return (unsigned)__builtin_amdgcn_s_getreg((3 << 11) | 20) & 0xFu; }
#define XB_SPIN(cond, bar) do { unsigned _sp = 0; while (cond) { __builtin_amdgcn_s_sleep(1); \
    if ((++_sp & 255u) == 0u) { if (xb_ld(&(bar)[XB_TMO])) break; if (_sp > XB_SPIN_CAP) { atomicAdd(&(bar)[XB_TMO], 1u); break; } } } } while (0)

struct XcdBarrier { unsigned* bar; unsigned x; volatile LAS unsigned* st; };

__device__ __forceinline__ XcdBarrier xcd_barrier_post(unsigned* bar, volatile LAS unsigned* st) {
    XcdBarrier b; b.bar = bar; b.x = xb_xcc_id(); b.st = st;
    if (threadIdx.x == 0) (void)xb_add(&bar[XB_XCNT(b.x)], 1u);
    return b;
}
__device__ __forceinline__ void xcd_barrier_complete(unsigned* bar, unsigned x, unsigned& nloc, unsigned& nx) {
    const unsigned G = gridDim.x * gridDim.y * gridDim.z;
    unsigned sum, cnt, mine, sp = 0u;
    for (;;) {
        sum = 0u; cnt = 0u; mine = 0u;
#pragma unroll
        for (unsigned j = 0; j < 16; ++j) { const unsigned c = xb_ld(&bar[XB_XCNT(j)]); sum += c; cnt += (c > 0u) ? 1u : 0u; mine = (j == x) ? c : mine; }
        if (sum == G) break;
        __builtin_amdgcn_s_sleep(1);
        if ((++sp & 255u) == 0u) { if (xb_ld(&bar[XB_TMO])) break; if (sp > XB_SPIN_CAP) { atomicAdd(&bar[XB_TMO], 1u); break; } }
    }
    nloc = mine > 0u ? mine : 1u; nx = cnt > 0u ? cnt : 1u;
}
__device__ __forceinline__ void xcd_barrier(const XcdBarrier& b) {
    asm volatile("s_waitcnt vmcnt(0)" ::: "memory");
    __syncthreads();
    if (threadIdx.x == 0) {
        unsigned* bar = b.bar;
        __builtin_amdgcn_s_waitcnt(0);
        unsigned nloc = b.st[0], nx = b.st[1];
        if (nloc == 0u) { xcd_barrier_complete(bar, b.x, nloc, nx); b.st[0] = nloc; b.st[1] = nx; }
        const unsigned old = xb_add(&bar[XB_XSUB(b.x)], 1u);
        const unsigned gen = old / nloc;
        if (old + 1u == (gen + 1u) * nloc) {
            __builtin_amdgcn_fence(__ATOMIC_RELEASE, "agent");
            asm volatile("s_waitcnt vmcnt(0)" ::: "memory");
            const unsigned og = xb_add(&bar[XB_TOP], 1u);
            const unsigned tg = og / nx;
            if (og + 1u == (tg + 1u) * nx) xb_add(&bar[XB_TOPGEN], 1u);
            else XB_SPIN(xb_ld(&bar[XB_TOPGEN]) == tg, bar);
            __builtin_amdgcn_fence(__ATOMIC_ACQUIRE, "agent");
            xb_add(&bar[XB_XGEN(b.x)], 1u);
            asm volatile("s_waitcnt vmcnt(0)" ::: "memory");
        } else {
            XB_SPIN(xb_ld(&bar[XB_XGEN(b.x)]) == gen, bar);
            __builtin_amdgcn_fence(__ATOMIC_ACQUIRE, "agent");
            asm volatile("s_waitcnt vmcnt(0)" ::: "memory");
        }
    }
    __syncthreads();
}

namespace pg8 {
constexpr int BM = 256, BK = 64, HALF = 128, HTB = HALF * BK * 2, STAGE_BYTES = 8 * HTB;
__host__ __device__ __forceinline__ int lds_byte(int r, int c) { const int st = (r >> 4) * 2 + (c >> 5), rr = r & 15, cc = c & 31, ob = rr * 64 + cc * 2; return st * 1024 + (ob ^ (((ob >> 9) & 1) << 5)); }
__host__ __device__ __forceinline__ void stage_rc(int b, int& R, int& C) { const int st = b / 1024, sb = b % 1024, swz = sb ^ (((sb >> 9) & 1) << 5); R = (st >> 1) * 16 + swz / 64; C = (st & 1) * 32 + (swz % 64) / 2; }
__host__ __device__ __forceinline__ int perm32(int rho) { const int n = rho >> 4, i = rho & 15; return 8 * (i >> 2) + 4 * n + (i & 3); }

struct Unit { int pm, pn, grp; };

struct StaticOrder {
    int nM, nN, nwg, G, c;
    __device__ void init(int M, int N, int G_, int c_) { nM = M / BM; nN = N / BM; nwg = nM * nN; G = G_; c = c_; }
    __device__ bool next(int i, Unit& u) const {
        const long L = (long)i * G + c; if (L >= nwg) return false;
        int wgid = (int)L; { const int q = nwg / 8, r = nwg % 8, xcd = wgid % 8, off = wgid / 8; wgid = (xcd < r ? xcd * (q + 1) : r * (q + 1) + (xcd - r) * q) + off; }
        const int nig = 8 * nN, gid = wgid / nig, fm = gid * 8, gsz = (nM - fm) < 8 ? (nM - fm) : 8;
        u.pm = fm + ((wgid % nig) % gsz); u.pn = (wgid % nig) / gsz; u.grp = 0; return true;
    }
};
template <int NPN_LOG2, bool REV = false> struct GroupOrder {
    int G, x, s, per, slots;
    __device__ void init(int G_, int c) { G = G_; if (G % 8 == 0) { x = c % 8; s = c / 8; slots = G / 8; per = (512 << NPN_LOG2) / 8; } else { x = 0; s = c; slots = G; per = 512 << NPN_LOG2; } }
    __device__ bool next(int i, Unit& u) const {
        if (i * slots + s >= per) return false;
        const int rounds = (per - s + slots - 1) / slots;
        const int w = (REV ? (rounds - 1 - i) : i) * slots + s;
        const int per_e = 32 << NPN_LOG2;
        int e, r;
        if (G % 8 == 0) { e = 2 * x + w / per_e; r = w % per_e; } else { e = w / per_e; r = w % per_e; }
        int bt, pn;
        if (NPN_LOG2 == 3) {
            const int ph = r >> 7, rr = (r >> 5) & 3, sl = r & 31; bt = rr * 8 + (sl & 7); pn = ph * 4 + (sl >> 3);
        } else { bt = r >> NPN_LOG2; pn = r & ((1 << NPN_LOG2) - 1); }
        u.pn = pn; u.pm = bt & 1; u.grp = (bt >> 1) * NE + e; return true;
    }
};

struct PlainAB {
    static constexpr bool GATHER = false;
    const bf16_t* A; const bf16_t* Bt; int K;
    __device__ __forceinline__ const char* a_base(const Unit& u) const { return (const char*)A + (size_t)u.pm * BM * K * 2; }
    __device__ __forceinline__ const char* b_base(const Unit& u) const { return (const char*)Bt + (size_t)u.pn * BM * K * 2; }
    __device__ __forceinline__ int gidx(const Unit&, int) const { return 0; }
};
struct GroupAB {
    static constexpr bool GATHER = false;
    const bf16_t* A; const bf16_t* Bt; int K; int N;
    __device__ __forceinline__ const char* a_base(const Unit& u) const { return (const char*)A + ((size_t)u.grp * 512 + (size_t)u.pm * BM) * K * 2; }
    __device__ __forceinline__ const char* b_base(const Unit& u) const { return (const char*)Bt + ((size_t)(u.grp & (NE - 1)) * N + (size_t)u.pn * BM) * K * 2; }
    __device__ __forceinline__ int gidx(const Unit&, int) const { return 0; }
};
struct GatherAB {
    static constexpr bool GATHER = true;
    const bf16_t* X; const int* idx; const bf16_t* Bt; int K; int N;
    __device__ __forceinline__ const char* a_base(const Unit& u) const { return (const char*)X + (size_t)(u.grp / NE) * SEQ * K * 2; }
    __device__ __forceinline__ const char* b_base(const Unit& u) const { return (const char*)Bt + ((size_t)(u.grp & (NE - 1)) * N + (size_t)u.pn * BM) * K * 2; }
    __device__ __forceinline__ int gidx(const Unit& u, int r) const { return idx[u.grp * CAP + u.pm * BM + r]; }
};

template <class Epi, class Sched, class AB>
__device__ __forceinline__ void gemm_phase(LAS unsigned char* lds, const AB ab, const Sched& S, const Epi& E) {
    int tid_ = threadIdx.x; asm volatile("" : "+v"(tid_));
    const int tid = tid_, wid = __builtin_amdgcn_readfirstlane(tid >> 6), lane = tid & 63, wr = wid >> 2, wc = wid & 3, fr = lane & 15, fq = lane >> 4;
    const int K = ab.K, nt = K / BK;
    unsigned voffA[2][2], voffB[2];
    int Rr[2], Cc[2];
#pragma unroll
    for (int i = 0; i < 2; ++i) { int R, C; stage_rc(tid * 16 + i * 8192, R, C); Rr[i] = R; Cc[i] = C; const int Rb = Epi::PERM ? ((R & ~31) + perm32(R & 31)) : R;
        voffA[0][i] = (unsigned)(R * K + C) * 2u; voffA[1][i] = voffA[0][i]; voffB[i] = (unsigned)(Rb * K + C) * 2u; }
    const size_t kstep = (size_t)(BK * 2);
    const size_t hstepB = (size_t)HALF * K * 2;
    const size_t hstepA = AB::GATHER ? 0 : hstepB;
    const unsigned ldsw = (unsigned)wid * 1024u;
    const int aoff = lds_byte(wr * 64 + fr, fq * 8), boff = lds_byte(wc * 32 + fr, fq * 8);
#define PG8_SA(b, h) (((b) * 2 + (h)) * HTB)
#define PG8_SB(b, h) ((4 + (b) * 2 + (h)) * HTB)
#define PG8_STAGE(bufoff, gbase, voff) do { _Pragma("unroll") for (int _i = 0; _i < 2; ++_i) \
        __builtin_amdgcn_global_load_lds((const unsigned*)((const char*)(gbase) + (voff)[_i]), (LAS unsigned*)(lds + (bufoff) + ldsw + _i * 8192), 16, 0, 0); } while (0)
#define PG8_LDA(dst, b, h) do { _Pragma("unroll") for (int m = 0; m < 4; ++m) _Pragma("unroll") for (int k = 0; k < 2; ++k) dst[m][k] = *(const LAS bf16x8*)(lds + PG8_SA(b, h) + aoff + m * 2048 + k * 1024); } while (0)
#define PG8_LDB(dst, b, h) do { _Pragma("unroll") for (int n = 0; n < 2; ++n) _Pragma("unroll") for (int k = 0; k < 2; ++k) dst[n][k] = *(const LAS bf16x8*)(lds + PG8_SB(b, h) + boff + n * 2048 + k * 1024); } while (0)
#define PG8_MMA(ai, bj, At, Bt) do { __builtin_amdgcn_s_setprio(1); _Pragma("unroll") for (int m = 0; m < 4; ++m) _Pragma("unroll") for (int n = 0; n < 2; ++n) _Pragma("unroll") for (int k = 0; k < 2; ++k) \
        acc[ai][bj][m][n] = __builtin_amdgcn_mfma_f32_16x16x32_bf16(Bt[n][k], At[m][k], acc[ai][bj][m][n], 0, 0, 0); __builtin_amdgcn_s_setprio(0); } while (0)
#define PG8_WAIT_V(n) asm volatile("s_waitcnt vmcnt(" #n ")" ::: "memory")
#define PG8_WAIT_L(n) asm volatile("s_waitcnt lgkmcnt(" #n ")" ::: "memory")
#define PG8_BAR __builtin_amdgcn_s_barrier()
#define PG8_SCHED __builtin_amdgcn_sched_barrier(0)
    Unit cur, nxt; int ui = 0;
    if (!S.next(0, cur)) return;
    __builtin_amdgcn_s_waitcnt(0);
    f32x4 acc[2][2][4][2];
#pragma unroll
    for (int a = 0; a < 2; ++a)
#pragma unroll
        for (int b = 0; b < 2; ++b)
#pragma unroll
            for (int m = 0; m < 4; ++m)
#pragma unroll
                for (int n = 0; n < 2; ++n) acc[a][b][m][n] = (f32x4){0.f, 0.f, 0.f, 0.f};
    bf16x8 At[4][2], B0[2][2], B1[2][2];
    const char* cA = ab.a_base(cur); const char* cB = ab.b_base(cur);
    if constexpr (AB::GATHER) {
#pragma unroll
        for (int h = 0; h < 2; ++h)
#pragma unroll
            for (int i = 0; i < 2; ++i) voffA[h][i] = (unsigned)(ab.gidx(cur, h * HALF + Rr[i]) * K + Cc[i]) * 2u;
    }
    PG8_STAGE(PG8_SB(0, 0), cB, voffB); PG8_STAGE(PG8_SB(0, 1), cB + hstepB, voffB); PG8_STAGE(PG8_SA(0, 0), cA, voffA[0]); PG8_STAGE(PG8_SA(0, 1), cA + hstepA, voffA[1]);
    if (wr == 1) PG8_BAR;
    PG8_WAIT_V(2); PG8_BAR;
    PG8_STAGE(PG8_SB(1, 0), cB + kstep, voffB); PG8_STAGE(PG8_SA(1, 0), cA + kstep, voffA[0]); PG8_STAGE(PG8_SB(1, 1), cB + hstepB + kstep, voffB);
    PG8_WAIT_V(6); PG8_BAR;
    for (;;) {
        const bool has_next = S.next(ui + 1, nxt);
        const char* nA = has_next ? ab.a_base(nxt) : cA; const char* nB = has_next ? ab.b_base(nxt) : cB;
        for (int t = 0; t < nt; t += 2) {
            const bool last = (t == nt - 2);
            const char* a1 = cA + (size_t)(t + 1) * kstep;
            const char* a2 = last ? nA : cA + (size_t)(t + 2) * kstep; const char* b2 = last ? nB : cB + (size_t)(t + 2) * kstep;
            const char* a3 = a2 + kstep; const char* b3 = b2 + kstep;
            int nidx[2][2];
            if constexpr (AB::GATHER) { if (last && has_next) {
#pragma unroll
                for (int h = 0; h < 2; ++h)
#pragma unroll
                    for (int i = 0; i < 2; ++i) nidx[h][i] = ab.gidx(nxt, h * HALF + Rr[i]); } }
            PG8_LDB(B0, 0, 0); PG8_LDB(B1, 0, 1); PG8_SCHED; PG8_LDA(At, 0, 0); PG8_STAGE(PG8_SA(1, 1), a1 + hstepA, voffA[1]);
            PG8_WAIT_V(8); PG8_WAIT_L(0); PG8_BAR; PG8_MMA(0, 0, At, B0); PG8_MMA(0, 1, At, B1); PG8_BAR; PG8_SCHED;
            if constexpr (AB::GATHER) { if (last && has_next) {
#pragma unroll
                for (int h = 0; h < 2; ++h)
#pragma unroll
                    for (int i = 0; i < 2; ++i) voffA[h][i] = (unsigned)(nidx[h][i] * K + Cc[i]) * 2u; } }
            PG8_LDA(At, 0, 1); PG8_STAGE(PG8_SB(0, 0), b2, voffB); PG8_STAGE(PG8_SB(0, 1), b2 + hstepB, voffB); PG8_STAGE(PG8_SA(0, 0), a2, voffA[0]);
            PG8_WAIT_V(8); PG8_WAIT_L(0); PG8_BAR; PG8_MMA(1, 0, At, B0); PG8_MMA(1, 1, At, B1); PG8_BAR; PG8_SCHED;
            PG8_LDB(B0, 1, 0); PG8_LDB(B1, 1, 1); PG8_SCHED; PG8_LDA(At, 1, 0); PG8_STAGE(PG8_SA(0, 1), a2 + hstepA, voffA[1]);
            PG8_WAIT_V(8); PG8_WAIT_L(0); PG8_BAR; PG8_MMA(0, 0, At, B0); PG8_MMA(0, 1, At, B1); PG8_BAR; PG8_SCHED;
            PG8_LDA(At, 1, 1); PG8_STAGE(PG8_SB(1, 0), b3, voffB); PG8_STAGE(PG8_SB(1, 1), b3 + hstepB, voffB); PG8_STAGE(PG8_SA(1, 0), a3, voffA[0]);
            PG8_WAIT_V(8); PG8_WAIT_L(0); PG8_BAR; PG8_MMA(1, 0, At, B0); PG8_MMA(1, 1, At, B1); PG8_BAR; PG8_SCHED;
        }
        if (wr == 0) PG8_BAR;
        E(acc, cur, wr, wc, fr, fq);
        if (!has_next) break;
#pragma unroll
        for (int a = 0; a < 2; ++a)
#pragma unroll
            for (int b = 0; b < 2; ++b)
#pragma unroll
                for (int m = 0; m < 4; ++m)
#pragma unroll
                    for (int n = 0; n < 2; ++n) acc[a][b][m][n] = (f32x4){0.f, 0.f, 0.f, 0.f};
        cur = nxt; cA = nA; cB = nB; ++ui;
        if (wr == 1) PG8_BAR;
    }
    PG8_WAIT_V(0);
    PG8_BAR;
#undef PG8_SA
#undef PG8_SB
#undef PG8_STAGE
#undef PG8_LDA
#undef PG8_LDB
#undef PG8_MMA
#undef PG8_WAIT_V
#undef PG8_WAIT_L
#undef PG8_BAR
#undef PG8_SCHED
}


struct EpiRope {
    static constexpr bool PERM = true;
    bf16_t* O; const float* cosT; const float* sinT; const float* rs;
    __device__ __forceinline__ void operator()(const f32x4 (&acc)[2][2][4][2], const Unit& u, int wr, int wc, int fr, int fq) const {
        const int row0 = u.pm * BM + wr * 64 + fr;
        const int g4 = 4 * (4 * (wc & 1) + fq);
        bool rope[2]; float qs[2];
#pragma unroll
        for (int bj = 0; bj < 2; ++bj) { const int cb = u.pn * BM + bj * HALF; rope[bj] = (cb < 1024) || (cb >= 1536 && cb < 2176); qs[bj] = ((cb < 512) || (cb >= 1536 && cb < 2048)) ? QSCALE : 1.0f; }
#pragma unroll
        for (int ai = 0; ai < 2; ++ai) {
            f32x4 csv[4], snv[4]; float rsr[4];
#pragma unroll
            for (int m = 0; m < 4; ++m) { const int row = row0 + ai * HALF + m * 16, pos = row & (SEQ - 1); csv[m] = *(const f32x4*)(cosT + pos * 32 + g4); snv[m] = *(const f32x4*)(sinT + pos * 32 + g4); rsr[m] = rs[row]; }
#pragma unroll
            for (int m = 0; m < 4; ++m) {
                const int row = row0 + ai * HALF + m * 16;
                const float rsv = rsr[m];
                const f32x4 cs = csv[m], sn = snv[m];
                bf16_t* rowp = O + (size_t)row * INW + u.pn * BM + wc * 32 + 8 * fq;
#pragma unroll
                for (int bj = 0; bj < 2; ++bj) {
                    const f32x4 v0 = acc[ai][bj][m][0], v1 = acc[ai][bj][m][1];
                    const f32x4 ce = rope[bj] ? cs : (f32x4){1.f, 1.f, 1.f, 1.f}, se = rope[bj] ? sn : (f32x4){0.f, 0.f, 0.f, 0.f};
                    f32x4 o0 = v0 * ce - v1 * se, o1 = v1 * ce + v0 * se;
                    const float sc = qs[bj] * rsv; o0 = o0 * sc; o1 = o1 * sc;
                    u32x4 w; w.x = cvt_pk_bf16(o0[0], o0[1]); w.y = cvt_pk_bf16(o0[2], o0[3]); w.z = cvt_pk_bf16(o1[0], o1[1]); w.w = cvt_pk_bf16(o1[2], o1[3]);
                    *(u32x4*)(rowp + bj * HALF) = w;
                }
            }
            asm volatile("" ::: "memory");
        }
    }
};
struct EpiResid {
    static constexpr bool PERM = true;
    bf16_t* X;
    __device__ __forceinline__ void operator()(const f32x4 (&acc)[2][2][4][2], const Unit& u, int wr, int wc, int fr, int fq) const {
        const int row0 = u.pm * BM + wr * 64 + fr, col0 = u.pn * BM + wc * 32 + 8 * fq;
#pragma unroll
        for (int ai = 0; ai < 2; ++ai) {
            u32x4 rv[4][2];
#pragma unroll
            for (int m = 0; m < 4; ++m)
#pragma unroll
                for (int bj = 0; bj < 2; ++bj) rv[m][bj] = *(const u32x4*)(X + (size_t)(row0 + ai * HALF + m * 16) * DM + col0 + bj * HALF);
#pragma unroll
            for (int m = 0; m < 4; ++m)
#pragma unroll
                for (int bj = 0; bj < 2; ++bj) { const u32x4 q = rv[m][bj]; const f32x4 v0 = acc[ai][bj][m][0], v1 = acc[ai][bj][m][1];
                    u32x4 w; w.x = cvt_pk_bf16(bflo(q.x) + v0[0], bfhi(q.x) + v0[1]); w.y = cvt_pk_bf16(bflo(q.y) + v0[2], bfhi(q.y) + v0[3]);
                    w.z = cvt_pk_bf16(bflo(q.z) + v1[0], bfhi(q.z) + v1[1]); w.w = cvt_pk_bf16(bflo(q.w) + v1[2], bfhi(q.w) + v1[3]);
                    *(u32x4*)(X + (size_t)(row0 + ai * HALF + m * 16) * DM + col0 + bj * HALF) = w; }
        }
    }
};
struct EpiSwiglu {
    static constexpr bool PERM = true;
    bf16_t* H; const float* rss;
    __device__ __forceinline__ void operator()(const f32x4 (&acc)[2][2][4][2], const Unit& u, int wr, int wc, int fr, int fq) const {
        const int row0 = u.grp * CAP + u.pm * BM + wr * 64 + fr, col0 = u.pn * HALF + wc * 32 + 8 * fq;
        float rsa[2][4];
#pragma unroll
        for (int ai = 0; ai < 2; ++ai)
#pragma unroll
            for (int m = 0; m < 4; ++m) rsa[ai][m] = rss[row0 + ai * HALF + m * 16];
#pragma unroll
        for (int ai = 0; ai < 2; ++ai)
#pragma unroll
            for (int m = 0; m < 4; ++m) {
                float hv[8]; const float rsv = rsa[ai][m];
                const f32x2 c1 = {-LOG2E * rsv, -LOG2E * rsv}, c2 = {rsv * rsv, rsv * rsv}, one = {1.0f, 1.0f};
#pragma unroll
                for (int n = 0; n < 2; ++n)
#pragma unroll
                    for (int j = 0; j < 4; j += 2) {
                        const f32x2 g = {acc[ai][0][m][n][j], acc[ai][0][m][n][j + 1]}, up = {acc[ai][1][m][n][j], acc[ai][1][m][n][j + 1]};
                        const f32x2 t = g * c1; f32x2 d; d[0] = __builtin_amdgcn_exp2f(t[0]); d[1] = __builtin_amdgcn_exp2f(t[1]); d = d + one;
                        f32x2 r; r[0] = __builtin_amdgcn_rcpf(d[0]); r[1] = __builtin_amdgcn_rcpf(d[1]);
                        const f32x2 hh = (g * up) * c2 * r; hv[4 * n + j] = hh[0]; hv[4 * n + j + 1] = hh[1]; }
                u32x4 w; w.x = cvt_pk_bf16(hv[0], hv[1]); w.y = cvt_pk_bf16(hv[2], hv[3]); w.z = cvt_pk_bf16(hv[4], hv[5]); w.w = cvt_pk_bf16(hv[6], hv[7]);
                *(u32x4*)(H + (size_t)(row0 + ai * HALF + m * 16) * DF + col0) = w;
            }
    }
};
struct EpiDown {
    static constexpr bool PERM = true;
    bf16_t* Y; const float* gate;
    __device__ __forceinline__ void operator()(const f32x4 (&acc)[2][2][4][2], const Unit& u, int wr, int wc, int fr, int fq) const {
        const int row0 = u.grp * CAP + u.pm * BM + wr * 64 + fr, col0 = u.pn * BM + wc * 32 + 8 * fq;
        float gta[2][4];
#pragma unroll
        for (int ai = 0; ai < 2; ++ai)
#pragma unroll
            for (int m = 0; m < 4; ++m) gta[ai][m] = gate[row0 + ai * HALF + m * 16];
#pragma unroll
        for (int ai = 0; ai < 2; ++ai)
#pragma unroll
            for (int m = 0; m < 4; ++m) { const int row = row0 + ai * HALF + m * 16; const float gt = gta[ai][m];
#pragma unroll
                for (int bj = 0; bj < 2; ++bj) { const f32x4 v0 = acc[ai][bj][m][0] * gt, v1 = acc[ai][bj][m][1] * gt;
                    u32x4 w; w.x = cvt_pk_bf16(v0[0], v0[1]); w.y = cvt_pk_bf16(v0[2], v0[3]); w.z = cvt_pk_bf16(v1[0], v1[1]); w.w = cvt_pk_bf16(v1[2], v1[3]);
                    *(u32x4*)(Y + (size_t)row * DM + col0 + bj * HALF) = w; } }
    }
};
}

struct Params { const float* in[13]; float* out; unsigned char* ws; int ph_lo, ph_hi; };
enum { I_X = 0, I_WIN, I_WOUT, I_GATTN, I_GMIXA, I_GMIXB, I_SINK, I_GFFN, I_WROUTER, I_WGATE, I_WUP, I_WDOWN, I_GFINAL };
constexpr int NPH = 9;
constexpr int PH_TOTAL = DEPTH * NPH + 1;

struct Ctx {
    LAS unsigned char* lds;
    int tid, lane, wave, G, gw, NGW;
    const GAS float* const GAS* in; GAS float* out; GAS unsigned char* ws;
};

template <int MODE>
__device__ __forceinline__ int dst_row(int n) {
    if (MODE == 0) { if ((n < 1024) || (n >= 1536 && n < 2176)) { const int d = n & 63, base = n - d; const int p = (d < 32) ? (8 * (d >> 2) + (d & 3)) : (8 * ((d - 32) >> 2) + 4 + (d & 3)); return base + p; } return n; }
    if (MODE == 2) return (n >> 7) * 256 + (n & 127);
    if (MODE == 3) return (n >> 7) * 256 + 128 + (n & 127);
    return n;
}
template <int MODE>
__device__ __forceinline__ void transpose_item(const GAS float* W, int K, int N, bf16_t* WT, const GAS float* gain, LAS float* scr, int item, int lane) {
    const int nblk = N / 32, kb = item / nblk, nb = item % nblk, k0 = 64 * kb, n0 = 32 * nb;
    float wv[32];
#pragma unroll
    for (int i = 0; i < 32; ++i) wv[i] = W[(size_t)(k0 + 2 * i + (lane >> 5)) * N + n0 + (lane & 31)];
    const float g0 = gain ? gain[k0 + lane] : 1.0f;
#pragma unroll
    for (int i = 0; i < 32; ++i) { const int kk = 2 * i + (lane >> 5); const float gv = __shfl(g0, kk); scr[kk * 33 + (lane & 31)] = wv[i] * gv; }
    LDS_WAIT(); asm volatile("" ::: "memory");
    const int c = lane & 7;
#pragma unroll
    for (int j = 0; j < 4; ++j) { const int n = (lane >> 3) + 8 * j; const LAS float* s = scr + (8 * c) * 33 + n;
        u32x4 o; o.x = pk2(s[0 * 33], s[1 * 33]); o.y = pk2(s[2 * 33], s[3 * 33]); o.z = pk2(s[4 * 33], s[5 * 33]); o.w = pk2(s[6 * 33], s[7 * 33]);
        *(u32x4*)(WT + (size_t)dst_row<MODE>(n0 + n) * K + k0 + 8 * c) = o; }
    LDS_WAIT(); asm volatile("" ::: "memory");
}
__device__ __forceinline__ void sincos_acc(float x, float& s, float& c) {
    int j = (int)(x * 1.27323954473516f); j = (j + 1) & ~1;
    const float y = (float)j;
    float z = __builtin_fmaf(-y, 0.78515625f, x); z = __builtin_fmaf(-y, 2.4187564849853515625e-4f, z); z = __builtin_fmaf(-y, 3.77489497744594108e-8f, z);
    const float zz = z * z;
    const float ps = ((-1.9515295891e-4f * zz + 8.3321608736e-3f) * zz - 1.6666654611e-1f) * zz * z + z;
    const float pc = ((2.443315711809948e-5f * zz - 1.388731625493765e-3f) * zz + 4.166664568298827e-2f) * zz * zz - 0.5f * zz + 1.0f;
    const int q = (j >> 1) & 3;
    s = (q == 0) ? ps : (q == 1) ? pc : (q == 2) ? -ps : -pc;
    c = (q == 0) ? pc : (q == 1) ? -ps : (q == 2) ? -pc : ps;
}
__device__ __forceinline__ void phase_weights(const Ctx& c, int l) {
    LAS float* scr = (LAS float*)(c.lds + c.wave * 16384);
    bf16_t* Win = (bf16_t*)(c.ws + WS_WIN); bf16_t* Wout = (bf16_t*)(c.ws + WS_WOUT); bf16_t* Wgu = (bf16_t*)(c.ws + WS_WGU); bf16_t* Wd = (bf16_t*)(c.ws + WS_WD);
    constexpr int I_IN = 16 * (INW / 32), I_OUT = 16 * 32, I_EXP = 16 * 32;
    constexpr int NITEMS = I_IN + I_OUT + 3 * NE * I_EXP;
    for (int it = c.gw; it < NITEMS; it += c.NGW) {
        int r = it;
        if (r < I_IN) { transpose_item<0>(c.in[I_WIN] + (size_t)l * DM * INW, DM, INW, Win, c.in[I_GATTN] + l * DM, scr, r, c.lane); continue; } r -= I_IN;
        if (r < I_OUT) { const int k0 = 64 * (r / 32); const GAS float* ga = (k0 < 512) ? (c.in[I_GMIXA] + l * 512) : (c.in[I_GMIXB] + l * 512 - 512);
            transpose_item<1>(c.in[I_WOUT] + (size_t)l * DM * DM, DM, DM, Wout, ga, scr, r, c.lane); continue; } r -= I_OUT;
        const int which = r / (NE * I_EXP); r -= which * (NE * I_EXP); const int e = r / I_EXP; r -= e * I_EXP;
        const size_t eoff = ((size_t)l * NE + e) * DM * DF;
        if (which == 0) transpose_item<2>(c.in[I_WGATE] + eoff, DM, DF, Wgu + (size_t)e * 2 * DF * DM, c.in[I_GFFN] + l * DM, scr, r, c.lane);
        else if (which == 1) transpose_item<3>(c.in[I_WUP] + eoff, DM, DF, Wgu + (size_t)e * 2 * DF * DM, c.in[I_GFFN] + l * DM, scr, r, c.lane);
        else transpose_item<1>(c.in[I_WDOWN] + eoff, DF, DM, Wd + (size_t)e * DM * DF, nullptr, scr, r, c.lane);
    }
    if (l == 0) {
        float* cosT = (float*)(c.ws + WS_ROPE); float* sinT = cosT + SEQ * 32;
        for (int i = blockIdx.x * 512 + c.tid; i < SEQ * 32; i += c.G * 512) {
            const int pos = i >> 5, f = i & 31;
            double r = 1.0; for (int k = 0; k < f; ++k) r *= 0.74989420933245582730;
            const float inv = (float)r; const float ang = (float)pos * inv;
            float sv, cv; sincos_acc(ang, sv, cv); cosT[i] = cv; sinT[i] = sv;
        }
    }
}
__device__ __forceinline__ void phase_norm1(const Ctx& c, int l) {
    const bool fin = (l == DEPTH);
    const unsigned short* inv = (const unsigned short*)(c.ws + WS_INV);
    const bf16_t* ye = (const bf16_t*)(c.ws + WS_ATT);
    bf16_t* xb = (bf16_t*)(c.ws + WS_XB); float* rs1 = (float*)(c.ws + WS_RS1);
    constexpr int TT = 2;
    for (int t2 = c.gw; t2 < MTOK / TT; t2 += c.NGW) {
        float v[TT][16]; unsigned myinv[TT];
#pragma unroll
        for (int tk = 0; tk < TT; ++tk) { const int tok = TT * t2 + tk;
            if (l == 0) { const f32x4* xr = (const f32x4*)(c.in[I_X] + (size_t)tok * DM) + 2 * c.lane;
#pragma unroll
                for (int j = 0; j < 2; ++j) { const f32x4 a = xr[128 * j], b = xr[128 * j + 1]; v[tk][8 * j] = a[0]; v[tk][8 * j + 1] = a[1]; v[tk][8 * j + 2] = a[2]; v[tk][8 * j + 3] = a[3]; v[tk][8 * j + 4] = b[0]; v[tk][8 * j + 5] = b[1]; v[tk][8 * j + 6] = b[2]; v[tk][8 * j + 7] = b[3]; }
            } else { const u32x4* xr = (const u32x4*)(xb + (size_t)tok * DM) + c.lane;
#pragma unroll
                for (int j = 0; j < 2; ++j) { const u32x4 q = xr[64 * j]; v[tk][8 * j] = bflo(q.x); v[tk][8 * j + 1] = bfhi(q.x); v[tk][8 * j + 2] = bflo(q.y); v[tk][8 * j + 3] = bfhi(q.y); v[tk][8 * j + 4] = bflo(q.z); v[tk][8 * j + 5] = bfhi(q.z); v[tk][8 * j + 6] = bflo(q.w); v[tk][8 * j + 7] = bfhi(q.w); } }
            myinv[tk] = (l > 0) ? (unsigned)inv[((size_t)(tok >> 12) * NE + (c.lane & 15)) * SEQ + (tok & (SEQ - 1))] : 0xFFFFu; }
        if (l > 0) {
#pragma unroll
            for (int tk = 0; tk < TT; ++tk) {
                const int tok = TT * t2 + tk, b = tok >> 12;
                unsigned long long mask = __ballot((c.lane < 16) && (myinv[tk] != 0xFFFFu));
                while (mask) {
                    const int e1 = __builtin_ctzll(mask); mask &= mask - 1;
                    const bool two = (mask != 0ull); const int e2 = two ? __builtin_ctzll(mask) : e1; if (two) mask &= mask - 1;
                    const unsigned c1 = (unsigned)__builtin_amdgcn_readlane((int)myinv[tk], e1), c2 = (unsigned)__builtin_amdgcn_readlane((int)myinv[tk], e2);
                    const u32x4* y1 = (const u32x4*)(ye + ((size_t)(b * NE + e1) * CAP + c1) * DM) + c.lane;
                    const u32x4* y2 = (const u32x4*)(ye + ((size_t)(b * NE + e2) * CAP + c2) * DM) + c.lane;
                    u32x4 w1[2], w2[2];
#pragma unroll
                    for (int j = 0; j < 2; ++j) { w1[j] = y1[64 * j]; w2[j] = y2[64 * j]; }
                    const float f2 = two ? 1.0f : 0.0f;
#pragma unroll
                    for (int j = 0; j < 2; ++j) {
                        v[tk][8 * j] += bflo(w1[j].x) + f2 * bflo(w2[j].x); v[tk][8 * j + 1] += bfhi(w1[j].x) + f2 * bfhi(w2[j].x);
                        v[tk][8 * j + 2] += bflo(w1[j].y) + f2 * bflo(w2[j].y); v[tk][8 * j + 3] += bfhi(w1[j].y) + f2 * bfhi(w2[j].y);
                        v[tk][8 * j + 4] += bflo(w1[j].z) + f2 * bflo(w2[j].z); v[tk][8 * j + 5] += bfhi(w1[j].z) + f2 * bfhi(w2[j].z);
                        v[tk][8 * j + 6] += bflo(w1[j].w) + f2 * bflo(w2[j].w); v[tk][8 * j + 7] += bfhi(w1[j].w) + f2 * bfhi(w2[j].w); }
                }
            }
        }
#pragma unroll
        for (int tk = 0; tk < TT; ++tk) {
            const int tok = TT * t2 + tk;
            float ss = 0.f;
#pragma unroll
            for (int i = 0; i < 16; ++i) ss += v[tk][i] * v[tk][i];
            const float rs = 1.0f / sqrtf(wave_sum(ss) * (1.0f / DM) + RMS_EPS);
            if (fin) {
                const f32x4* gf = (const f32x4*)c.in[I_GFINAL] + 2 * c.lane;
                f32x4* orow = (f32x4*)(c.out + (size_t)tok * DM) + 2 * c.lane;
#pragma unroll
                for (int j = 0; j < 2; ++j) { const f32x4 g0 = gf[128 * j], g1 = gf[128 * j + 1];
                    orow[128 * j] = (f32x4){v[tk][8 * j] * rs * g0[0], v[tk][8 * j + 1] * rs * g0[1], v[tk][8 * j + 2] * rs * g0[2], v[tk][8 * j + 3] * rs * g0[3]};
                    orow[128 * j + 1] = (f32x4){v[tk][8 * j + 4] * rs * g1[0], v[tk][8 * j + 5] * rs * g1[1], v[tk][8 * j + 6] * rs * g1[2], v[tk][8 * j + 7] * rs * g1[3]}; }
            } else {
                u32x4* xo = (u32x4*)(xb + (size_t)tok * DM) + c.lane;
#pragma unroll
                for (int j = 0; j < 2; ++j) { u32x4 w; w.x = pk2(v[tk][8 * j], v[tk][8 * j + 1]); w.y = pk2(v[tk][8 * j + 2], v[tk][8 * j + 3]); w.z = pk2(v[tk][8 * j + 4], v[tk][8 * j + 5]); w.w = pk2(v[tk][8 * j + 6], v[tk][8 * j + 7]); xo[64 * j] = w; }
                if (c.lane == 0) rs1[tok] = rs;
            }
        }
    }
}

typedef short s16x4 __attribute__((ext_vector_type(4)));
typedef float f32x16 __attribute__((ext_vector_type(16)));
constexpr int KROW = 144;
constexpr int ATT_NKMAX = 384;
constexpr int ATT_V_OFF = ATT_NKMAX * KROW;
constexpr float MASKED = -3.0e38f, M_INIT = -1.0e30f;
__device__ __forceinline__ float swap_max(float m) { auto rr = __builtin_amdgcn_permlane32_swap(__float_as_uint(m), __float_as_uint(m), false, false); return fmaxf(__uint_as_float(rr[0]), __uint_as_float(rr[1])); }
__device__ __forceinline__ float swap_sum(float m) { auto rr = __builtin_amdgcn_permlane32_swap(__float_as_uint(m), __float_as_uint(m), false, false); return __uint_as_float(rr[0]) + __uint_as_float(rr[1]); }
__device__ __forceinline__ s16x4 vtr(LAS const char* p) { typedef short v4i16_t __attribute__((ext_vector_type(4))); return __builtin_bit_cast(s16x4, __builtin_amdgcn_ds_read_tr16_b64_v4i16((LAS v4i16_t*)p)); }

constexpr float ATT_THR = 8.0f;
#ifndef ATT_STAGGER
#define ATT_STAGGER 8
#endif
struct AttnSt { LAS const char* kp; LAS const char* vp; int vhalf, absbase, n, r, h; bool edge; float m, lsum; };
template <int BLK> __device__ __forceinline__ void attn_kread(const AttnSt& st, bf16x8 (&kf)[4]) {
#pragma unroll
    for (int cc = 0; cc < 4; ++cc) kf[cc] = *(LAS const bf16x8*)(st.kp + BLK * 32 * KROW + cc * 32);
}
__device__ __forceinline__ void attn_qk(const bf16x8 (&qf)[4], const bf16x8 (&kf)[4], const AttnSt& st, f32x16& S) {
    const float ninit = -st.m;
#pragma unroll
    for (int i = 0; i < 16; ++i) S[i] = ninit;
#pragma unroll
    for (int cc = 0; cc < 4; ++cc) S = __builtin_amdgcn_mfma_f32_32x32x16_bf16(kf[cc], qf[cc], S, 0, 0, 0);
}
template <int NB, int BLK>
__device__ __forceinline__ void attn_blocks(const bf16x8 (&qf)[4], AttnSt& st, f32x16& S, f32x16 (&O)[2]) {
    if constexpr (BLK < NB) {
        bf16x8 vf[2][2], kf[4];
#pragma unroll
        for (int sx = 0; sx < 2; ++sx)
#pragma unroll
            for (int t = 0; t < 2; ++t) { LAS const char* vq = st.vp + t * st.vhalf + (BLK * 32 + 16 * sx) * 64; const s16x4 lo = vtr(vq), hi = vtr(vq + 8 * 64);
                vf[sx][t] = __builtin_shufflevector(lo, hi, 0, 1, 2, 3, 4, 5, 6, 7); }
        if constexpr (BLK + 1 < NB) attn_kread<BLK + 1>(st, kf);
        __builtin_amdgcn_sched_barrier(0);
        const int r = st.r, h = st.h;
        if (BLK == 0 || BLK == NB - 1 || st.edge) {
            int L = -(st.absbase + 32 * BLK) - 4 * h, U = st.n - 1 - st.absbase - 32 * BLK - 4 * h;
            if (BLK == 0) L = max(L, r - 4 * h);
            if (BLK == NB - 1) U = min(U, r - 4 * h);
#pragma unroll
            for (int i = 0; i < 16; ++i) { const int ci = (i & 3) + 8 * (i >> 2); S[i] = (ci >= L && ci <= U) ? S[i] : MASKED; }
        }
        float mloc = fmaxf(fmaxf(S[0], S[1]), S[2]);
#pragma unroll
        for (int i = 3; i < 15; i += 2) mloc = fmaxf(fmaxf(mloc, S[i]), S[i + 1]);
        mloc = fmaxf(mloc, S[15]);
        mloc = swap_max(mloc);
        if (BLK == 0) {
            const float d = (mloc < -1.0e37f) ? 0.f : mloc;
#pragma unroll
            for (int i = 0; i < 16; ++i) S[i] -= d;
            st.m = d;
        } else if (__builtin_amdgcn_ballot_w64(mloc > ATT_THR) != 0ull) {
            const float d = fmaxf(mloc, 0.f), al = __builtin_amdgcn_exp2f(-d);
#pragma unroll
            for (int i = 0; i < 16; ++i) S[i] -= d;
#pragma unroll
            for (int t = 0; t < 2; ++t)
#pragma unroll
                for (int i = 0; i < 16; ++i) O[t][i] *= al;
            st.lsum *= al; st.m += d;
        }
        float ps = 0.f;
#pragma unroll
        for (int i = 0; i < 16; ++i) { S[i] = __builtin_amdgcn_exp2f(S[i]); ps += S[i]; }
        st.lsum += ps;
        bf16x8 pf[2];
#pragma unroll
        for (int sx = 0; sx < 2; ++sx) {
            u32x4 pw; pw.x = cvt_pk_bf16(S[8 * sx], S[8 * sx + 1]); pw.y = cvt_pk_bf16(S[8 * sx + 2], S[8 * sx + 3]); pw.z = cvt_pk_bf16(S[8 * sx + 4], S[8 * sx + 5]); pw.w = cvt_pk_bf16(S[8 * sx + 6], S[8 * sx + 7]);
            pf[sx] = __builtin_bit_cast(bf16x8, pw); }
        __builtin_amdgcn_s_setprio(1);
        if constexpr (BLK + 1 < NB) attn_qk(qf, kf, st, S);
#pragma unroll
        for (int sx = 0; sx < 2; ++sx)
#pragma unroll
            for (int t = 0; t < 2; ++t) O[t] = __builtin_amdgcn_mfma_f32_32x32x16_bf16(vf[sx][t], pf[sx], O[t], 0, 0, 0);
        __builtin_amdgcn_s_setprio(0);
        attn_blocks<NB, BLK + 1>(qf, st, S, O);
    }
}
template <int NB>
__device__ __forceinline__ void attn_core(const bf16x8 (&qf)[4], LAS const char* Kb, LAS const char* Vb, int vhalf, int kb0, int absbase, int n, int lane,
                                          f32x16 (&O)[2], float& m_out, float& l_out) {
    AttnSt st; st.r = lane & 31; st.h = lane >> 5; st.vhalf = vhalf; st.absbase = absbase; st.n = n;
    st.kp = Kb + (kb0 * 32 + st.r) * KROW + st.h * 16;
    st.vp = Vb + (kb0 * 32 + 4 * st.h + ((lane & 15) >> 2)) * 64 + ((lane >> 4) & 1) * 32 + (lane & 3) * 8;
    st.edge = (absbase < 0) || (absbase + 32 * NB > n);
    st.m = 0.f; st.lsum = 0.f;
#pragma unroll
    for (int t = 0; t < 2; ++t)
#pragma unroll
        for (int i = 0; i < 16; ++i) O[t][i] = 0.f;
    f32x16 S; bf16x8 kf0[4];
    if (__builtin_amdgcn_readfirstlane(threadIdx.x >> 8)) __builtin_amdgcn_s_sleep(ATT_STAGGER);
    attn_kread<0>(st, kf0);
    attn_qk(qf, kf0, st, S);
    attn_blocks<NB, 0>(qf, st, S, O);
    m_out = st.m; l_out = swap_sum(st.lsum);
}
__device__ __forceinline__ void attn_store(const f32x16 (&O)[2], float scale, bf16_t* dst, int h) {
#pragma unroll
    for (int t = 0; t < 2; ++t)
#pragma unroll
        for (int gp = 0; gp < 2; ++gp) { const int g0 = 2 * gp, g1 = 2 * gp + 1;
            unsigned ax = cvt_pk_bf16(O[t][4 * g0] * scale, O[t][4 * g0 + 1] * scale), ay = cvt_pk_bf16(O[t][4 * g0 + 2] * scale, O[t][4 * g0 + 3] * scale);
            unsigned bx = cvt_pk_bf16(O[t][4 * g1] * scale, O[t][4 * g1 + 1] * scale), by = cvt_pk_bf16(O[t][4 * g1 + 2] * scale, O[t][4 * g1 + 3] * scale);
            { auto rr = __builtin_amdgcn_permlane32_swap(ax, bx, false, false); ax = rr[0]; bx = rr[1]; }
            { auto rr = __builtin_amdgcn_permlane32_swap(ay, by, false, false); ay = rr[0]; by = rr[1]; }
            u32x4 w; w.x = ax; w.y = ay; w.z = bx; w.w = by;
            *(u32x4*)(dst + 32 * t + 16 * gp + 8 * h) = w; }
}
constexpr size_t ATT_P_STRIDE = (size_t)MTOK * 512;
struct AJob { int b, head, pat, d, cls, qt, n; };
__device__ __forceinline__ AJob a_decode(int job, int G) { AJob j; int j48, bh;
    if (G == 256) { const int x = job & 7, jx = job >> 3; j48 = jx % 48; bh = (jx / 48) * 8 + x; } else { j48 = job % 48; bh = job / 48; }
    j.head = bh & 7; j.b = bh >> 3; j.pat = j48 >> 4; const int sub = j48 & 15;
    if (j.pat == 0) { j.d = 1; j.cls = 0; j.qt = sub; } else if (j.pat == 1) { j.d = 4; j.cls = sub & 3; j.qt = sub >> 2; } else { j.d = 16; j.cls = sub; j.qt = 0; }
    j.n = SEQ / j.d; return j; }
__device__ __forceinline__ void phase_attn_mfma(const Ctx& c, int l) {
    const bf16_t* proj = (const bf16_t*)(c.ws + WS_PROJ);
    bf16_t* oP = (bf16_t*)(c.ws + WS_ATT); float* lse = (float*)(c.ws + WS_LSE);
    LAS char* Kl = (LAS char*)c.lds; LAS char* Vl = (LAS char*)c.lds + ATT_V_OFF;
    const int tid = c.tid, lane = c.lane, wave = c.wave, r = lane & 31, h = lane >> 5;
    {
        constexpr int NJ = BATCH * 8 * 48;
        u32x4 kreg[6], vreg[6]; bf16x8 qf[4];
#define A_LOAD(job_) do { const AJob j_ = a_decode(job_, c.G); const int kabs0_ = 256 * j_.qt - 64; const bf16_t* pb_ = proj + (size_t)j_.b * SEQ * INW; \
        _Pragma("unroll") for (int it = 0; it < 6; ++it) { const int pi = tid + 512 * it, key = pi >> 3, part = pi & 7, jk = kabs0_ + key; const bool ok = (jk >= 0) && (jk < j_.n); \
            const bf16_t* src = pb_ + (size_t)(j_.cls + j_.d * (ok ? jk : 0)) * INW + j_.head * 64 + part * 8; \
            kreg[it] = ok ? *(const u32x4*)(src + 512) : (u32x4){0u, 0u, 0u, 0u}; vreg[it] = ok ? *(const u32x4*)(src + 1024) : (u32x4){0u, 0u, 0u, 0u}; } } while (0)
#define A_QLOAD(job_) do { const AJob j_ = a_decode(job_, c.G); const int qtok_ = j_.cls + j_.d * (256 * j_.qt + 32 * wave + r); \
        const bf16_t* qp_ = proj + ((size_t)j_.b * SEQ + qtok_) * INW + j_.head * 64 + 8 * h; \
        _Pragma("unroll") for (int cc = 0; cc < 4; ++cc) qf[cc] = *(const bf16x8*)(qp_ + 16 * cc); } while (0)
        int job = blockIdx.x;
        if (job < NJ) { A_LOAD(job); A_QLOAD(job); }
        for (; job < NJ; job += c.G) {
            const AJob j = a_decode(job, c.G);
#pragma unroll
            for (int it = 0; it < 6; ++it) { const int pi = tid + 512 * it, key = pi >> 3, part = pi & 7;
                *(LAS u32x4*)(Kl + key * KROW + part * 16) = kreg[it];
                *(LAS u32x4*)(Vl + (part >> 2) * (ATT_NKMAX * 64) + key * 64 + (part & 3) * 16) = vreg[it]; }
            __syncthreads();
            if (job + c.G < NJ) A_LOAD(job + c.G);
            f32x16 O[2]; float m, ls;
            attn_core<5>(qf, Kl, Vl, ATT_NKMAX * 64, wave, 256 * j.qt + 32 * wave - 64, j.n, lane, O, m, ls);
            if (job + c.G < NJ) A_QLOAD(job + c.G);
            const size_t trow = (size_t)j.b * SEQ + j.cls + j.d * (256 * j.qt + 32 * wave + r);
            attn_store(O, 1.0f / ls, oP + (size_t)j.pat * ATT_P_STRIDE + trow * 512 + j.head * 64, h);
            if (h == 0) lse[((size_t)j.pat * MTOK + trow) * 8 + j.head] = m + __builtin_amdgcn_logf(ls);
            __syncthreads();
        }
#undef A_LOAD
#undef A_QLOAD
    }
    {
        constexpr int NJ = BATCH * 2 * 64;
        u32x4 kreg[5], vreg[5]; bf16x8 qf[4];
#define B_DEC(job_, tt_, kvh_, b_) int tt_, kvh_, b_; do { if (c.G == 256) { const int x_ = (job_) & 7, jx_ = (job_) >> 3; tt_ = jx_ & 63; const int pr_ = (jx_ >> 6) * 8 + x_; kvh_ = pr_ & 1; b_ = pr_ >> 1; } else { tt_ = (job_) & 63; kvh_ = ((job_) >> 6) & 1; b_ = (job_) >> 7; } } while (0)
#define B_LOAD(job_) do { B_DEC(job_, tt_, kvh_, b_); const int kabs0_ = 64 * tt_ - 128; const bf16_t* pb_ = proj + (size_t)b_ * SEQ * INW; \
        _Pragma("unroll") for (int it = 0; it < 5; ++it) { const int pi = tid + 512 * it, key = pi >> 3, part = pi & 7, jk = kabs0_ + key; const bool ok = (jk >= 0) && (jk < SEQ); \
            const bf16_t* src = pb_ + (size_t)(ok ? jk : 0) * INW + kvh_ * 64 + part * 8; \
            kreg[it] = ok ? *(const u32x4*)(src + 2048) : (u32x4){0u, 0u, 0u, 0u}; vreg[it] = ok ? *(const u32x4*)(src + 2176) : (u32x4){0u, 0u, 0u, 0u}; } } while (0)
#define B_QLOAD(job_) do { B_DEC(job_, tt_, kvh_, b_); const int g_ = kvh_ * 4 + (wave >> 1), qtok_ = 64 * tt_ + 32 * (wave & 1) + r; \
        const bf16_t* qp_ = proj + ((size_t)b_ * SEQ + qtok_) * INW + 1536 + g_ * 64 + 8 * h; \
        _Pragma("unroll") for (int cc = 0; cc < 4; ++cc) qf[cc] = *(const bf16x8*)(qp_ + 16 * cc); } while (0)
        int job = blockIdx.x;
        if (job < NJ) { B_LOAD(job); B_QLOAD(job); }
        for (; job < NJ; job += c.G) {
            B_DEC(job, tt, kvh, b);
            const int g = kvh * 4 + (wave >> 1), qtok = 64 * tt + 32 * (wave & 1) + r;
#pragma unroll
            for (int it = 0; it < 5; ++it) { const int pi = tid + 512 * it, key = pi >> 3, part = pi & 7;
                *(LAS u32x4*)(Kl + key * KROW + part * 16) = kreg[it];
                *(LAS u32x4*)(Vl + (part >> 2) * (ATT_NKMAX * 64) + key * 64 + (part & 3) * 16) = vreg[it]; }
            __syncthreads();
            if (job + c.G < NJ) B_LOAD(job + c.G);
            f32x16 O[2]; float m, ls;
            attn_core<9>(qf, Kl, Vl, ATT_NKMAX * 64, wave & 1, 64 * tt + 32 * (wave & 1) - 128, SEQ, lane, O, m, ls);
            if (job + c.G < NJ) B_QLOAD(job + c.G);
            const float s2 = c.in[I_SINK][l * 8 + g] * LOG2E, mf = fmaxf(m, s2), al = __builtin_amdgcn_exp2f(m - mf);
            const float lt = ls * al + __builtin_amdgcn_exp2f(s2 - mf);
            attn_store(O, al / lt, oP + 3 * ATT_P_STRIDE + ((size_t)b * SEQ + qtok) * 512 + g * 64, h);
            __syncthreads();
        }
#undef B_LOAD
#undef B_QLOAD
#undef B_DEC
    }
}
__device__ __forceinline__ void phase_merge_norm(const Ctx& c) {
    const bf16_t* oP = (const bf16_t*)(c.ws + WS_ATT); const float* lse = (const float*)(c.ws + WS_LSE); bf16_t* mix = (bf16_t*)(c.ws + WS_ACT);
    const int lane = c.lane, head = lane >> 3;
    constexpr int TT = 2;
    for (int t2 = c.gw; t2 < MTOK / TT; t2 += c.NGW) {
        float lq[TT][3]; u32x4 aq[TT][4];
#pragma unroll
        for (int tk = 0; tk < TT; ++tk) { const int tok = TT * t2 + tk;
#pragma unroll
            for (int p = 0; p < 3; ++p) lq[tk][p] = lse[((size_t)p * MTOK + tok) * 8 + head];
#pragma unroll
            for (int p = 0; p < 4; ++p) aq[tk][p] = *((const u32x4*)(oP + (size_t)p * ATT_P_STRIDE + (size_t)tok * 512) + lane); }
#pragma unroll
        for (int tk = 0; tk < TT; ++tk) {
            const int tok = TT * t2 + tk;
            const float l0 = lq[tk][0], l1 = lq[tk][1], l2 = lq[tk][2];
            const float mx = fmaxf(l0, fmaxf(l1, l2));
            float w0 = __builtin_amdgcn_exp2f(l0 - mx), w1 = __builtin_amdgcn_exp2f(l1 - mx), w2 = __builtin_amdgcn_exp2f(l2 - mx);
            const float iw = 1.0f / (w0 + w1 + w2); w0 *= iw; w1 *= iw; w2 *= iw;
            const u32x4 a0 = aq[tk][0], a1 = aq[tk][1], a2 = aq[tk][2], bq = aq[tk][3];
            const unsigned x0[4] = {a0.x, a0.y, a0.z, a0.w}, x1[4] = {a1.x, a1.y, a1.z, a1.w}, x2[4] = {a2.x, a2.y, a2.z, a2.w}, xb[4] = {bq.x, bq.y, bq.z, bq.w};
            float av[8], bv[8]; float sa = 0.f, sb = 0.f;
#pragma unroll
            for (int i = 0; i < 4; ++i) { av[2 * i] = w0 * bflo(x0[i]) + w1 * bflo(x1[i]) + w2 * bflo(x2[i]); av[2 * i + 1] = w0 * bfhi(x0[i]) + w1 * bfhi(x1[i]) + w2 * bfhi(x2[i]);
                bv[2 * i] = bflo(xb[i]); bv[2 * i + 1] = bfhi(xb[i]); }
#pragma unroll
            for (int i = 0; i < 8; ++i) { sa += av[i] * av[i]; sb += bv[i] * bv[i]; }
            const float ra = 1.0f / sqrtf(wave_sum(sa) * (1.0f / 512) + RMS_EPS), rb = 1.0f / sqrtf(wave_sum(sb) * (1.0f / 512) + RMS_EPS);
            u32x4 oa, ob; oa.x = pk2(av[0] * ra, av[1] * ra); oa.y = pk2(av[2] * ra, av[3] * ra); oa.z = pk2(av[4] * ra, av[5] * ra); oa.w = pk2(av[6] * ra, av[7] * ra);
            ob.x = pk2(bv[0] * rb, bv[1] * rb); ob.y = pk2(bv[2] * rb, bv[3] * rb); ob.z = pk2(bv[4] * rb, bv[5] * rb); ob.w = pk2(bv[6] * rb, bv[7] * rb);
            *((u32x4*)(mix + (size_t)tok * DM) + lane) = oa; *((u32x4*)(mix + (size_t)tok * DM + 512) + lane) = ob;
        }
    }
}

__device__ __forceinline__ void phase_norm2_router(const Ctx& c, int l) {
    LAS u32x4* wh = (LAS u32x4*)c.lds; LAS u32x4* wl = wh + 32 * 64;
    const GAS float* wsrc = c.in[I_WROUTER] + (size_t)l * DM * NE; const GAS float* gf = c.in[I_GFFN] + l * DM;
    for (int i = c.tid; i < 32 * 64; i += 512) { const int ks = i >> 6, ln = i & 63, e = ln & 15, g = ln >> 4;
        unsigned hi[8], lo[8];
#pragma unroll
        for (int j = 0; j < 8; ++j) { const int k = 32 * ks + 8 * g + j; const float w = wsrc[k * NE + e] * gf[k]; hi[j] = f2bf(w); lo[j] = f2bf(w - bflo(hi[j])); }
        wh[i] = (u32x4){hi[0] | (hi[1] << 16), hi[2] | (hi[3] << 16), hi[4] | (hi[5] << 16), hi[6] | (hi[7] << 16)};
        wl[i] = (u32x4){lo[0] | (lo[1] << 16), lo[2] | (lo[3] << 16), lo[4] | (lo[5] << 16), lo[6] | (lo[7] << 16)}; }
    __syncthreads();
    const bf16_t* xb = (const bf16_t*)(c.ws + WS_XB); float* rs2 = (float*)(c.ws + WS_RS2); float* aff = (float*)(c.ws + WS_AFF);
    const int lane = c.lane, e = lane & 15, g = lane >> 4;
    for (int tile = c.gw; tile < MTOK / 16; tile += c.NGW) {
        const int tok0 = tile * 16;
        const u32x4* xr = (const u32x4*)(xb + (size_t)(tok0 + e) * DM) + g;
        f32x4 L = {0.f, 0.f, 0.f, 0.f}, Q = {0.f, 0.f, 0.f, 0.f};
        int wlane = lane; asm volatile("" : "+v"(wlane));
#pragma unroll
        for (int kb = 0; kb < 32; kb += 8) {
            u32x4 xv[8];
#pragma unroll
            for (int i = 0; i < 8; ++i) xv[i] = xr[4 * (kb + i)];
#pragma unroll
            for (int i = 0; i < 8; ++i) { const bf16x8 a = __builtin_bit_cast(bf16x8, xv[i]);
                const u32x4 bh = wh[(kb + i) * 64 + wlane], bl = wl[(kb + i) * 64 + wlane];
                L = __builtin_amdgcn_mfma_f32_16x16x32_bf16(a, __builtin_bit_cast(bf16x8, bh), L, 0, 0, 0);
                L = __builtin_amdgcn_mfma_f32_16x16x32_bf16(a, __builtin_bit_cast(bf16x8, bl), L, 0, 0, 0);
                Q = __builtin_amdgcn_mfma_f32_16x16x32_bf16(a, a, Q, 0, 0, 0); }
        }
        float lg[4];
        const float q0 = Q[0], q1 = Q[1], q2 = Q[2], q3 = Q[3];
        const float s0 = __builtin_bit_cast(float, __builtin_amdgcn_ds_bpermute((16 * g + 4 * g + 0) << 2, __builtin_bit_cast(int, q0)));
        const float s1 = __builtin_bit_cast(float, __builtin_amdgcn_ds_bpermute((16 * g + 4 * g + 1) << 2, __builtin_bit_cast(int, q1)));
        const float s2 = __builtin_bit_cast(float, __builtin_amdgcn_ds_bpermute((16 * g + 4 * g + 2) << 2, __builtin_bit_cast(int, q2)));
        const float s3 = __builtin_bit_cast(float, __builtin_amdgcn_ds_bpermute((16 * g + 4 * g + 3) << 2, __builtin_bit_cast(int, q3)));
        f32x4 rsv; rsv[0] = 1.0f / sqrtf(s0 * (1.0f / DM) + RMS_EPS); rsv[1] = 1.0f / sqrtf(s1 * (1.0f / DM) + RMS_EPS); rsv[2] = 1.0f / sqrtf(s2 * (1.0f / DM) + RMS_EPS); rsv[3] = 1.0f / sqrtf(s3 * (1.0f / DM) + RMS_EPS);
        if (e == 0) *(f32x4*)(rs2 + tok0 + 4 * g) = rsv;
        f32x4 av;
#pragma unroll
        for (int r = 0; r < 4; ++r) { lg[r] = L[r] * rsv[r];
            float mx = lg[r];
            mx = fmaxf(mx, __shfl_xor(mx, 1)); mx = fmaxf(mx, __shfl_xor(mx, 2)); mx = fmaxf(mx, __shfl_xor(mx, 4)); mx = fmaxf(mx, __shfl_xor(mx, 8));
            const float ex = expf(lg[r] - mx);
            float sm = ex; sm += __shfl_xor(sm, 1); sm += __shfl_xor(sm, 2); sm += __shfl_xor(sm, 4); sm += __shfl_xor(sm, 8);
            av[r] = ex / sm; }
        *(f32x4*)(aff + ((size_t)(tok0 >> 12) * NE + e) * SEQ + (tok0 & (SEQ - 1)) + 4 * g) = av;
    }
    __syncthreads();
}

__device__ __forceinline__ void phase_topk(const Ctx& c) {
    LAS unsigned* hist = (LAS unsigned*)c.lds;
    LAS unsigned* misc = hist + 256;
    const float* aff = (const float*)(c.ws + WS_AFF);
    int* idx = (int*)(c.ws + WS_IDX); float* gate = (float*)(c.ws + WS_GATE); unsigned short* inv = (unsigned short*)(c.ws + WS_INV);
    const float* rs2 = (const float*)(c.ws + WS_RS2); float* rss = (float*)(c.ws + WS_RSS);
    const int tid = c.tid, lane = c.lane, wave = c.wave;
    for (int u = blockIdx.x; u < BATCH * NE; u += c.G) {
        const int b = u / NE, e = u % NE;
        const f32x4* ap = (const f32x4*)(aff + (size_t)u * SEQ) + 2 * tid;
        const f32x4 a0 = ap[0], a1 = ap[1];
        const float av[8] = {a0[0], a0[1], a0[2], a0[3], a1[0], a1[1], a1[2], a1[3]};
        unsigned key[8];
#pragma unroll
        for (int i = 0; i < 8; ++i) key[i] = __float_as_uint(av[i]);
        unsigned prefix = 0u, kneed = CAP;
#pragma unroll
        for (int pass = 0; pass < 4; ++pass) {
            const int shift = 24 - 8 * pass;
            if (tid < 256) hist[tid] = 0u;
            __syncthreads();
#pragma unroll
            for (int i = 0; i < 8; ++i) { const bool match = (pass == 0) ? true : ((key[i] >> (shift + 8)) == prefix); if (match) __hip_atomic_fetch_add(&hist[(key[i] >> shift) & 255u], 1u, __ATOMIC_RELAXED, __HIP_MEMORY_SCOPE_WORKGROUP); }
            __syncthreads();
            if (wave == 0) {
                unsigned hb[4]; unsigned s4 = 0u;
#pragma unroll
                for (int i = 0; i < 4; ++i) { hb[i] = hist[4 * lane + i]; s4 += hb[i]; }
                unsigned suf = s4;
#pragma unroll
                for (int off = 1; off < 64; off <<= 1) { const unsigned t = __shfl_down(suf, off); if (lane + off < 64) suf += t; }
                unsigned cum = suf - s4;
#pragma unroll
                for (int i = 3; i >= 0; --i) { if (cum < kneed && kneed <= cum + hb[i]) { misc[0] = 4u * lane + i; misc[1] = kneed - cum; } cum += hb[i]; }
            }
            __syncthreads();
            prefix = (prefix << 8) | misc[0]; kneed = misc[1];
            __syncthreads();
        }
        const unsigned T = prefix;
        unsigned cg = 0u, ce = 0u;
#pragma unroll
        for (int i = 0; i < 8; ++i) { cg += (key[i] > T) ? 1u : 0u; ce += (key[i] == T) ? 1u : 0u; }
        const unsigned packed = cg | (ce << 16);
        unsigned inc = packed;
#pragma unroll
        for (int off = 1; off < 64; off <<= 1) { const unsigned t = __shfl_up(inc, off); if (lane >= off) inc += t; }
        if (lane == 63) misc[8 + wave] = inc;
        __syncthreads();
        unsigned wbase = 0u;
#pragma unroll
        for (int w = 0; w < 8; ++w) if (w < wave) wbase += misc[8 + w];
        const unsigned excl = wbase + inc - packed;
        unsigned gbefore = excl & 0xffffu, ebefore = excl >> 16;
#pragma unroll
        for (int i = 0; i < 8; ++i) {
            const int s = tid * 8 + i;
            const bool gt = key[i] > T, eq = key[i] == T;
            const bool sel = gt || (eq && ebefore < kneed);
            const unsigned slot = gbefore + (ebefore < kneed ? ebefore : kneed);
            if (sel) { idx[u * CAP + slot] = s; gate[u * CAP + slot] = av[i]; rss[u * CAP + slot] = rs2[b * SEQ + s]; }
            inv[(size_t)u * SEQ + s] = sel ? (unsigned short)slot : (unsigned short)0xFFFFu;
            gbefore += gt ? 1u : 0u; ebefore += eq ? 1u : 0u;
        }
        __syncthreads();
    }
}


__device__ __forceinline__ void refresh(Ctx& c, const Params& a) {
    int t = threadIdx.x; asm volatile("" : "+v"(t)); c.tid = t; c.lane = t & 63;
    unsigned wl = (unsigned)(uintptr_t)a.ws, wh = (unsigned)((uintptr_t)a.ws >> 32); asm volatile("" : "+v"(wl), "+v"(wh));
    wl = (unsigned)__builtin_amdgcn_readfirstlane((int)wl); wh = (unsigned)__builtin_amdgcn_readfirstlane((int)wh);
    c.ws = (GAS unsigned char*)(((uintptr_t)wh << 32) | (uintptr_t)wl);
    const uintptr_t kp = (uintptr_t)__builtin_amdgcn_kernarg_segment_ptr();
    unsigned kl = (unsigned)kp, kh = (unsigned)(kp >> 32); asm volatile("" : "+v"(kl), "+v"(kh));
    kl = (unsigned)__builtin_amdgcn_readfirstlane((int)kl); kh = (unsigned)__builtin_amdgcn_readfirstlane((int)kh);
    c.in = (const GAS float* const GAS*)(((uintptr_t)kh << 32) | (uintptr_t)kl);
}
__global__ void __launch_bounds__(512, 2) fwd_kernel(Params args) {
    extern __shared__ __attribute__((aligned(16))) unsigned char lds_raw[];
    Ctx c;
    c.lds = (LAS unsigned char*)lds_raw;
    c.tid = threadIdx.x; c.lane = c.tid & 63; c.wave = __builtin_amdgcn_readfirstlane(c.tid >> 6);
    c.G = gridDim.x; c.gw = blockIdx.x * 8 + c.wave; c.NGW = c.G * 8;
    c.out = (GAS float*)args.out; c.ws = (GAS unsigned char*)args.ws;
    volatile LAS unsigned* MISC = (volatile LAS unsigned*)(c.lds + MISC_OFF);
    if (c.tid < 16) MISC[c.tid] = 0u;
    __syncthreads();
    const int lo = args.ph_lo, hi = args.ph_hi;
    XcdBarrier bar; bar.bar = (unsigned*)(c.ws + WS_CTL); bar.x = 0; bar.st = MISC + 8;
    if (hi - lo > 1) bar = xcd_barrier_post((unsigned*)(c.ws + WS_CTL), MISC + 8);
#define IN(k) (lo <= (k) && (k) < hi)
#define SEAM(k) do { if (IN(k) && IN((k) + 1)) xcd_barrier(bar); } while (0)

    for (int l = 0; l < DEPTH; ++l) {
        const int p0 = l * NPH;
        if (IN(p0 + 0)) { refresh(c, args); phase_weights(c, l); phase_norm1(c, l); }
        SEAM(p0 + 0);
        if (IN(p0 + 1)) { refresh(c, args);
            pg8::PlainAB ab{(const bf16_t*)(c.ws + WS_XB), (const bf16_t*)(c.ws + WS_WIN), DM};
            pg8::StaticOrder S; S.init(MTOK, INW, c.G, (int)blockIdx.x);
            pg8::EpiRope E{(bf16_t*)(c.ws + WS_PROJ), (const float*)(c.ws + WS_ROPE), (const float*)(c.ws + WS_ROPE) + SEQ * 32, (const float*)(c.ws + WS_RS1)};
            pg8::gemm_phase<pg8::EpiRope, pg8::StaticOrder, pg8::PlainAB>(c.lds, ab, S, E);
        }
        SEAM(p0 + 1);
        if (IN(p0 + 2)) { refresh(c, args); phase_attn_mfma(c, l); }
        SEAM(p0 + 2);
        if (IN(p0 + 3)) { refresh(c, args); phase_merge_norm(c); }
        SEAM(p0 + 3);
        if (IN(p0 + 4)) { refresh(c, args);
            pg8::PlainAB ab{(const bf16_t*)(c.ws + WS_ACT), (const bf16_t*)(c.ws + WS_WOUT), DM};
            pg8::StaticOrder S; S.init(MTOK, DM, c.G, (int)blockIdx.x);
            pg8::EpiResid E{(bf16_t*)(c.ws + WS_XB)};
            pg8::gemm_phase<pg8::EpiResid, pg8::StaticOrder, pg8::PlainAB>(c.lds, ab, S, E);
        }
        SEAM(p0 + 4);
        if (IN(p0 + 5)) { refresh(c, args); phase_norm2_router(c, l); }
        SEAM(p0 + 5);
        if (IN(p0 + 6)) { refresh(c, args); phase_topk(c); }
        SEAM(p0 + 6);
        if (IN(p0 + 7)) { refresh(c, args);
            pg8::GatherAB ab{(const bf16_t*)(c.ws + WS_XB), (const int*)(c.ws + WS_IDX), (const bf16_t*)(c.ws + WS_WGU), DM, 2 * DF};
            pg8::GroupOrder<3> S; S.init(c.G, (int)blockIdx.x);
            pg8::EpiSwiglu E{(bf16_t*)(c.ws + WS_PROJ), (const float*)(c.ws + WS_RSS)};
            pg8::gemm_phase<pg8::EpiSwiglu, pg8::GroupOrder<3>, pg8::GatherAB>(c.lds, ab, S, E);
        }
        SEAM(p0 + 7);
        if (IN(p0 + 8)) { refresh(c, args);
            pg8::GroupAB ab{(const bf16_t*)(c.ws + WS_PROJ), (const bf16_t*)(c.ws + WS_WD), DF, DM};
            pg8::GroupOrder<2, true> S; S.init(c.G, (int)blockIdx.x);
            pg8::EpiDown E{(bf16_t*)(c.ws + WS_ATT), (const float*)(c.ws + WS_GATE)};
            pg8::gemm_phase<pg8::EpiDown, pg8::GroupOrder<2, true>, pg8::GroupAB>(c.lds, ab, S, E);
        }
        SEAM(p0 + 8);
    }
    if (IN(DEPTH * NPH)) { refresh(c, args); phase_norm1(c, DEPTH); }
#undef IN
#undef SEAM
}

extern "C" void kernel_launch(void* const* d_in, const int* in_sizes, int n_in, void* d_out, int out_size, void* d_ws, size_t ws_size, hipStream_t stream) {
    static int grid = 0;
    if (grid == 0) {
        if (n_in != 13 || out_size != MTOK * DM || ws_size < WS_END) { fprintf(stderr, "kernel_launch: unexpected shapes (n_in %d, out %d, ws %zu)\n", n_in, out_size, ws_size); grid = -1; return; }
        int dev = 0, cus = 0, per_cu = 0;
        if (hipGetDevice(&dev) != hipSuccess || hipDeviceGetAttribute(&cus, hipDeviceAttributeMultiprocessorCount, dev) != hipSuccess) { grid = -1; return; }
        if (hipFuncSetAttribute((const void*)fwd_kernel, hipFuncAttributeMaxDynamicSharedMemorySize, LDS_BYTES) != hipSuccess) { fprintf(stderr, "kernel_launch: hipFuncSetAttribute failed\n"); grid = -1; return; }
        if (hipOccupancyMaxActiveBlocksPerMultiprocessor(&per_cu, (const void*)fwd_kernel, 512, LDS_BYTES) != hipSuccess || per_cu < 1) fprintf(stderr, "kernel_launch: occupancy query reports %d\n", per_cu);
        (void)hipGetLastError();
        grid = cus;
    }
    if (grid < 0) return;
    (void)hipMemsetAsync((char*)d_ws + WS_CTL, 0, CTL_ZERO_BYTES, stream);
    Params p{};
    for (int i = 0; i < 13; ++i) p.in[i] = (const float*)d_in[i];
    p.out = (float*)d_out; p.ws = (unsigned char*)d_ws;
    p.ph_lo = 0; p.ph_hi = PH_TOTAL;
    hipLaunchKernelGGL(fwd_kernel, dim3(grid), dim3(512), LDS_BYTES, stream, p);
}
```
